# Optimizing an MI355X kernel written in HIP

```python
import math
import jax, jax.numpy as jnp
from jax import lax
import numpy as np

D_MODEL = 2048
BATCH = 16
SEQ = 2048
DEPTH = 2

D_PLE = 256
D_MIX = D_MODEL
D_SGU = D_MIX // 2
D_SSM = D_MIX - D_SGU
SGU_CHUNK = 128
SGU_HEAD = 128
SGU_HEADS = D_SGU // SGU_HEAD
SSM_GROUP = 16
SSM_GROUPS = D_SSM // SSM_GROUP
SSM_STATE = 64
D_FF = 5632
CONV_W = 3
EPS = 1e-6
DT_MIN = 1e-3
DT_MAX = 1e-1

kernel_name = "hybrid_sgu_s5_convffn_ple"


def rmsnorm(x, g):
    x32 = x.astype(jnp.float32)
    y = x32 * lax.rsqrt(jnp.mean(x32 * x32, axis=-1, keepdims=True) + EPS)
    return (y * g.astype(jnp.float32)).astype(x.dtype)


def layernorm(x, g):
    x32 = x.astype(jnp.float32)
    xc = x32 - jnp.mean(x32, axis=-1, keepdims=True)
    y = xc * lax.rsqrt(jnp.mean(xc * xc, axis=-1, keepdims=True) + EPS)
    return (y * g.astype(jnp.float32)).astype(x.dtype)


def spatial_gating(u, v, g, w_s, b_s):
    bsz, seq, _ = u.shape
    v = layernorm(v, g)
    v = v.reshape(bsz, seq // SGU_CHUNK, SGU_CHUNK, SGU_HEADS, SGU_HEAD)
    mask = jnp.tril(jnp.ones((SGU_CHUNK, SGU_CHUNK), dtype=w_s.dtype))
    v = jnp.einsum('hts,bnshc->bnthc', w_s * mask[None], v)
    v = v + jnp.transpose(b_s)[None, None, :, :, None]
    return u * v.reshape(bsz, seq, D_SGU)


def cmul(ar, ai, br, bi):
    return ar * br - ai * bi, ar * bi + ai * br


def s5_combine(left, right):
    al_r, al_i, bl_r, bl_i = left
    ar_r, ar_i, br_r, br_i = right
    a_r, a_i = cmul(ar_r, ar_i, al_r, al_i)
    ab_r, ab_i = cmul(ar_r, ar_i, bl_r, bl_i)
    return a_r, a_i, ab_r + br_r, ab_i + br_i


def s5_mixer(xs, lam_re, lam_im, log_dt, b_re, b_im, c_re, c_im, d, glu_w, glu_b):
    f32 = jnp.float32
    dtype = xs.dtype
    bsz, seq, _ = xs.shape
    x32 = xs.astype(f32)
    xg = x32.reshape(bsz, seq, SSM_GROUPS, SSM_GROUP)
    lr = lam_re.astype(f32)
    li = lam_im.astype(f32)
    dt = jnp.exp(log_dt.astype(f32))[:, None]
    mag = jnp.exp(lr * dt)
    ab_r = mag * jnp.cos(li * dt)
    ab_i = mag * jnp.sin(li * dt)
    den = lr * lr + li * li
    nr = ab_r - 1.0
    q_r = (nr * lr + ab_i * li) / den
    q_i = (ab_i * lr - nr * li) / den
    b_re32 = b_re.astype(f32)
    b_im32 = b_im.astype(f32)
    bb_r = q_r[..., None] * b_re32 - q_i[..., None] * b_im32
    bb_i = q_r[..., None] * b_im32 + q_i[..., None] * b_re32
    bu_r = jnp.einsum('gnc,bsgc->bsgn', bb_r, xg)
    bu_i = jnp.einsum('gnc,bsgc->bsgn', bb_i, xg)
    a_r = jnp.broadcast_to(ab_r, bu_r.shape)
    a_i = jnp.broadcast_to(ab_i, bu_i.shape)
    _, _, s_r, s_i = lax.associative_scan(s5_combine, (a_r, a_i, bu_r, bu_i), axis=1)
    y = (jnp.einsum('gcn,bsgn->bsgc', c_re.astype(f32), s_r)
         - jnp.einsum('gcn,bsgn->bsgc', c_im.astype(f32), s_i))
    y = y.reshape(bsz, seq, D_SSM) + d.astype(f32) * x32
    z = jax.nn.gelu(y)
    z = z * jax.nn.sigmoid(z @ glu_w.astype(f32) + glu_b.astype(f32))
    return z.astype(dtype)


def conv_ffn(h, w_up, conv_w, conv_b, w_down):
    a = h @ w_up
    seq = a.shape[1]
    ap = jnp.pad(a, ((0, 0), (CONV_W - 1, 0), (0, 0)))
    c = (conv_w[0] * ap[:, 0:seq] + conv_w[1] * ap[:, 1:seq + 1]
         + conv_w[2] * ap[:, 2:seq + 2] + conv_b)
    gate, up = jnp.split(c, 2, axis=-1)
    return (jax.nn.silu(gate) * up) @ w_down


def setup_inputs(seed: int = 0) -> dict:
    key = jax.random.key(seed)
    ks = iter(jax.random.split(key, 40))
    nrm = lambda shape, s: jax.random.normal(next(ks), shape, jnp.float32) * s
    gain = lambda shape: 1.0 + nrm(shape, 0.05)
    x = jax.random.normal(next(ks), (BATCH, SEQ, D_MODEL), jnp.float32)
    p = jax.random.normal(next(ks), (DEPTH, BATCH, SEQ, D_PLE), jnp.float32)
    n_idx = jnp.arange(SSM_STATE, dtype=jnp.float32)
    lam_re = -0.5 + nrm((DEPTH, SSM_GROUPS, SSM_STATE), 0.01)
    lam_im = math.pi * n_idx + nrm((DEPTH, SSM_GROUPS, SSM_STATE), 0.01)
    log_dt = jax.random.uniform(next(ks), (DEPTH, SSM_GROUPS), jnp.float32,
                                math.log(DT_MIN), math.log(DT_MAX))
    return {
        "x": x,
        "p": p,
        "mix_norm": gain((DEPTH, D_MODEL)),
        "w_in": nrm((DEPTH, D_MODEL, D_SGU * 2 + D_SSM), D_MODEL ** -0.5),
        "sgu_norm": gain((DEPTH, D_SGU)),
        "sgu_w": nrm((DEPTH, SGU_HEADS, SGU_CHUNK, SGU_CHUNK), SGU_CHUNK ** -0.5),
        "sgu_b": 1.0 + nrm((DEPTH, SGU_HEADS, SGU_CHUNK), 0.1),
        "s5_lam_re": lam_re,
        "s5_lam_im": lam_im,
        "s5_log_dt": log_dt,
        "s5_b_re": nrm((DEPTH, SSM_GROUPS, SSM_STATE, SSM_GROUP), (2 * SSM_GROUP) ** -0.5),
        "s5_b_im": nrm((DEPTH, SSM_GROUPS, SSM_STATE, SSM_GROUP), (2 * SSM_GROUP) ** -0.5),
        "s5_c_re": nrm((DEPTH, SSM_GROUPS, SSM_GROUP, SSM_STATE), SSM_STATE ** -0.5),
        "s5_c_im": nrm((DEPTH, SSM_GROUPS, SSM_GROUP, SSM_STATE), SSM_STATE ** -0.5),
        "s5_d": nrm((DEPTH, D_SSM), 1.0),
        "s5_glu_w": nrm((DEPTH, D_SSM, D_SSM), D_SSM ** -0.5),
        "s5_glu_b": nrm((DEPTH, D_SSM), 0.02),
        "out_norm_a": gain((DEPTH, D_SGU)),
        "out_norm_b": gain((DEPTH, D_SSM)),
        "w_out": nrm((DEPTH, D_MIX, D_MODEL), D_MIX ** -0.5),
        "ffn_norm": gain((DEPTH, D_MODEL)),
        "ffn_w_up": nrm((DEPTH, D_MODEL, 2 * D_FF), D_MODEL ** -0.5),
        "ffn_conv_w": nrm((DEPTH, CONV_W, 2 * D_FF), CONV_W ** -0.5),
        "ffn_conv_b": nrm((DEPTH, 2 * D_FF), 0.02),
        "ffn_w_down": nrm((DEPTH, D_FF, D_MODEL), D_FF ** -0.5),
        "ple_norm": gain((DEPTH, D_MODEL)),
        "ple_w_gate": nrm((DEPTH, D_MODEL, D_MODEL), D_MODEL ** -0.5),
        "ple_w_proj": nrm((DEPTH, D_PLE, D_MODEL), D_PLE ** -0.5),
        "final_norm": gain((D_MODEL,)),
    }


def reference(x, p, mix_norm, w_in, sgu_norm, sgu_w, sgu_b, s5_lam_re, s5_lam_im, s5_log_dt,
              s5_b_re, s5_b_im, s5_c_re, s5_c_im, s5_d, s5_glu_w, s5_glu_b,
              out_norm_a, out_norm_b, w_out, ffn_norm, ffn_w_up, ffn_conv_w, ffn_conv_b,
              ffn_w_down, ple_norm, ple_w_gate, ple_w_proj, final_norm):
    for i in range(DEPTH):
        h = rmsnorm(x, mix_norm[i])
        z = h @ w_in[i]
        u = jax.nn.gelu(z[..., :D_SGU])
        v = jax.nn.gelu(z[..., D_SGU:2 * D_SGU])
        xs = z[..., 2 * D_SGU:]
        ya = spatial_gating(u, v, sgu_norm[i], sgu_w[i], sgu_b[i])
        yb = s5_mixer(xs, s5_lam_re[i], s5_lam_im[i], s5_log_dt[i], s5_b_re[i], s5_b_im[i],
                      s5_c_re[i], s5_c_im[i], s5_d[i], s5_glu_w[i], s5_glu_b[i])
        mix = jnp.concatenate([rmsnorm(ya, out_norm_a[i]), rmsnorm(yb, out_norm_b[i])], axis=-1)
        x = x + mix @ w_out[i]
        x = x + conv_ffn(rmsnorm(x, ffn_norm[i]), ffn_w_up[i], ffn_conv_w[i], ffn_conv_b[i], ffn_w_down[i])
        gate = jax.nn.sigmoid(rmsnorm(x, ple_norm[i]) @ ple_w_gate[i])
        x = x + gate * (p[i] @ ple_w_proj[i])
    return rmsnorm(x, final_norm)
```

```cpp
#include <hip/hip_runtime.h>
#include <hip/hip_cooperative_groups.h>
#include <cstdio>
#include <cstdint>
namespace cg = cooperative_groups;

#ifndef MULTI_LAUNCH
#define MULTI_LAUNCH 0
#endif
#ifndef PH_MASK
#define PH_MASK 0x3FF
#endif
#define PHON(k) (((PH_MASK) >> (k)) & 1)
#ifndef DUP_MASK
#define DUP_MASK 0
#endif
#define DUPN(k) ((((DUP_MASK) >> (k)) & 1) ? 2 : 1)

#define LAS __attribute__((address_space(3)))
typedef unsigned short bf16_t;
typedef short bf16x8 __attribute__((ext_vector_type(8)));
typedef float f32x4 __attribute__((ext_vector_type(4)));
typedef float f32x2 __attribute__((ext_vector_type(2)));
typedef unsigned u32x4 __attribute__((ext_vector_type(4)));
typedef unsigned u32x2 __attribute__((ext_vector_type(2)));

constexpr int MTOK = 32768, SEQ = 2048, DM = 2048, NZ = 3072, DS = 1024, FF = 5632, NUP = 11264, DP = 256;
constexpr float EPS = 1e-6f;
constexpr size_t MiB = 1u << 20;
constexpr size_t WS_ST0 = 0, WS_ST1 = 4 * MiB, WS_VST = 8 * MiB, WS_YAST = 12 * MiB, WS_YBST = 16 * MiB, WS_S5P = 18 * MiB, WS_SGUW = 20 * MiB, WS_HALO = 22 * MiB;
constexpr size_t WS_W = 66 * MiB;
constexpr size_t W_IN = 0, W_GLU = 12 * MiB, W_OUT = 14 * MiB, W_UP = 22 * MiB, W_DOWN = 66 * MiB, W_GATE = 88 * MiB, W_PROJ = 96 * MiB, W_LAYER = 97 * MiB;
constexpr size_t WS_PB = 260 * MiB;
constexpr size_t WS_XB = 292 * MiB;
constexpr size_t WS_BIG = 420 * MiB;
constexpr size_t WS_Z = WS_BIG, WS_ZS = WS_BIG + 192 * MiB, WS_MIX = WS_BIG + 256 * MiB, WS_HID = WS_BIG;
constexpr size_t WS_PROJ = 804 * MiB;
constexpr size_t WS_CTL = 932 * MiB, CTL_BYTES = 16384;
constexpr size_t WS_END = 933 * MiB;
constexpr size_t S5_BCAT = 0, S5_CMT = 256 * 1024, S5_AA = 512 * 1024, S5_LAYER = 1 * MiB;

constexpr int LDS_RING = 131072, LDS_TAB = 24576, LDS_MISC = LDS_RING + LDS_TAB, LDS_BYTES = LDS_MISC + 64;

typedef __bf16 bf16x2_t __attribute__((ext_vector_type(2)));
__device__ __forceinline__ unsigned cvt_pk_bf16(float lo, float hi) { const f32x2 v = {lo, hi}; const bf16x2_t b = __builtin_convertvector(v, bf16x2_t); return __builtin_bit_cast(unsigned, b); }
__device__ __forceinline__ float bf_lo(unsigned u) { return __uint_as_float(u << 16); }
__device__ __forceinline__ float bf_hi(unsigned u) { return __uint_as_float(u & 0xffff0000u); }
__device__ __forceinline__ float fast_sigmoid(float x) { return __builtin_amdgcn_rcpf(1.0f + __builtin_amdgcn_exp2f(-1.44269504089f * x)); }
__device__ __forceinline__ float gelu_tanh(float x) {
    const float t = x * x;
    const float e = __builtin_amdgcn_exp2f(x * __builtin_fmaf(t, -0.10294324f, -2.30220818f));
    return x * __builtin_amdgcn_rcpf(1.0f + e);
}
__device__ __forceinline__ unsigned lnd(unsigned x) { asm volatile("" : "+v"(x)); return x; }
__device__ __forceinline__ int lane_id() { int z; asm volatile("v_mbcnt_lo_u32_b32 %0, -1, 0\n\tv_mbcnt_hi_u32_b32 %0, -1, %0" : "=v"(z)); return z; }
#define THREAD_ID() (g_wave * 64 + lane_id())
__device__ __forceinline__ float wave_sum(float v) {
#pragma unroll
    for (int o = 1; o < 64; o <<= 1) v += __shfl_xor(v, o);
    return v;
}
__device__ __forceinline__ float red_fq(float s) { s += __shfl_xor(s, 16); s += __shfl_xor(s, 32); return s; }
__device__ __forceinline__ float slots_sum32(const float* slots, int row) {
    const f32x4* p = (const f32x4*)(slots + (size_t)row * 32); float s = 0.f;
#pragma unroll
    for (int j = 0; j < 8; ++j) { const f32x4 q = p[j]; s += (q.x + q.y) + (q.z + q.w); }
    return s;
}
__device__ __forceinline__ float slots_sum16(const float* slots, int row) {
    const f32x4* p = (const f32x4*)(slots + (size_t)row * 16); float s = 0.f;
#pragma unroll
    for (int j = 0; j < 4; ++j) { const f32x4 q = p[j]; s += (q.x + q.y) + (q.z + q.w); }
    return s;
}

namespace pg8 {
constexpr int BM = 256, BK = 64, HALF = 128, HTB = HALF * BK * 2, STAGE_BYTES = 8 * HTB, NXCD = 8, WGM = 8;
__host__ __device__ __forceinline__ int lds_byte(int r, int c) { const int st = (r >> 4) * 2 + (c >> 5), rr = r & 15, cc = c & 31, ob = rr * 64 + cc * 2; return st * 1024 + (ob ^ (((ob >> 9) & 1) << 5)); }
__host__ __device__ __forceinline__ void stage_rc(int b, int& R, int& C) { const int st = b / 1024, sb = b % 1024, swz = sb ^ (((sb >> 9) & 1) << 5); R = (st >> 1) * 16 + swz / 64; C = (st & 1) * 32 + (swz % 64) / 2; }
__host__ __device__ __forceinline__ int perm32(int rho) { const int n = rho >> 4, i = rho & 15; return 8 * (i >> 2) + 4 * n + (i & 3); }

struct Unit { int pm, pn; };
struct Gemm { const bf16_t* A; const bf16_t* Bt; int M, N, K; };

struct StaticOrder {
    int nM, nN, nwg, G, c;
    __device__ void init(int M, int N, int G_, int c_) { nM = M / BM; nN = N / BM; nwg = nM * nN; G = G_; c = c_; }
    __device__ bool next(int i, Unit& u) const {
        const long L = (long)i * G + c; if (L >= nwg) return false;
        int wgid = (int)L; { const int q = nwg / NXCD, r = nwg % NXCD, xcd = wgid % NXCD, off = wgid / NXCD; wgid = (xcd < r ? xcd * (q + 1) : r * (q + 1) + (xcd - r) * q) + off; }
        const int nig = WGM * nN, gid = wgid / nig, fm = gid * WGM, gsz = (nM - fm) < WGM ? (nM - fm) : WGM;
        u.pm = fm + ((wgid % nig) % gsz); u.pn = (wgid % nig) / gsz; return true;
    }
};

template <bool ROWPERM> __device__ __forceinline__ int epi_row(const Unit& u, int ai, int m, int wr, int fr) {
    return ROWPERM ? (u.pm * BM + 128 * wr + 8 * fr + 4 * ai + m) : (u.pm * BM + 128 * ai + 64 * wr + 16 * m + fr);
}

template <class Epi>
__device__ __forceinline__ void gemm_phase(LAS unsigned char* lds, const Gemm g, const StaticOrder& S, const Epi& E, const int g_wave) {
    constexpr bool ROWPERM = Epi::ROWPERM;
    int tid_ = THREAD_ID(); asm volatile("" : "+v"(tid_));
    const int tid = tid_, wid = __builtin_amdgcn_readfirstlane(tid >> 6), lane = tid & 63, wr = wid >> 2, wc = wid & 3, fr = lane & 15, fq = lane >> 4;
    const int K = g.K, nt = K / BK;
    unsigned voffA[2], voffB[2];
#pragma unroll
    for (int i = 0; i < 2; ++i) { int R, C; stage_rc(tid * 16 + i * 8192, R, C); const int Rb = (R & ~31) + perm32(R & 31);
        const int Ra = ROWPERM ? (128 * (R >> 6) + 8 * (R & 15) + ((R >> 4) & 3)) : R;
        voffA[i] = (unsigned)(Ra * K + C) * 2u; voffB[i] = (unsigned)(Rb * K + C) * 2u; }
    const size_t kstep = (size_t)(BK * 2);
    const size_t hstepB = (size_t)HALF * K * 2;
    const size_t hstepA = ROWPERM ? (size_t)4 * K * 2 : hstepB;
    const size_t tstep = 2 * hstepB;
    const unsigned ldsw = (unsigned)wid * 1024u;
    const int aoff = lds_byte(wr * 64 + fr, fq * 8), boff = lds_byte(wc * 32 + fr, fq * 8);
#define PG8_SA(b, h) (((b) * 2 + (h)) * HTB)
#define PG8_SB(b, h) ((4 + (b) * 2 + (h)) * HTB)
#define PG8_STAGE(bufoff, gbase, voff) do { _Pragma("unroll") for (int _i = 0; _i < 2; ++_i) \
        __builtin_amdgcn_global_load_lds((const unsigned*)((const char*)(gbase) + (voff)[_i]), (LAS unsigned*)(lds + (bufoff) + ldsw + _i * 8192), 16, 0, 0); } while (0)
#define PG8_LDA(dst, b, h) do { _Pragma("unroll") for (int m = 0; m < 4; ++m) _Pragma("unroll") for (int k = 0; k < 2; ++k) dst[m][k] = *(const LAS bf16x8*)(lds + PG8_SA(b, h) + aoff + m * 2048 + k * 1024); } while (0)
#define PG8_LDB(dst, b, h) do { _Pragma("unroll") for (int n = 0; n < 2; ++n) _Pragma("unroll") for (int k = 0; k < 2; ++k) dst[n][k] = *(const LAS bf16x8*)(lds + PG8_SB(b, h) + boff + n * 2048 + k * 1024); } while (0)
#define PG8_MMA(ai, bj, At, Bt) do { __builtin_amdgcn_s_setprio(1); _Pragma("unroll") for (int m = 0; m < 4; ++m) _Pragma("unroll") for (int n = 0; n < 2; ++n) _Pragma("unroll") for (int k = 0; k < 2; ++k) \
        acc[ai][bj][m][n] = __builtin_amdgcn_mfma_f32_16x16x32_bf16(Bt[n][k], At[m][k], acc[ai][bj][m][n], 0, 0, 0); __builtin_amdgcn_s_setprio(0); } while (0)
#define PG8_WAIT_V(n) asm volatile("s_waitcnt vmcnt(" #n ")" ::: "memory")
#define PG8_WAIT_L(n) asm volatile("s_waitcnt lgkmcnt(" #n ")" ::: "memory")
#define PG8_BAR __builtin_amdgcn_s_barrier()
#define PG8_SCHED __builtin_amdgcn_sched_barrier(0)
    Unit cur, nxt; int ui = 0;
    if (!S.next(0, cur)) return;
    f32x4 acc[2][2][4][2];
#pragma unroll
    for (int a = 0; a < 2; ++a)
#pragma unroll
        for (int b = 0; b < 2; ++b)
#pragma unroll
            for (int m = 0; m < 4; ++m)
#pragma unroll
                for (int n = 0; n < 2; ++n) acc[a][b][m][n] = (f32x4){0.f, 0.f, 0.f, 0.f};
    bf16x8 At[4][2], B0[2][2], B1[2][2];
    const char* cA = (const char*)g.A + (size_t)cur.pm * tstep; const char* cB = (const char*)g.Bt + (size_t)cur.pn * tstep;
    PG8_STAGE(PG8_SB(0, 0), cB, voffB); PG8_STAGE(PG8_SB(0, 1), cB + hstepB, voffB); PG8_STAGE(PG8_SA(0, 0), cA, voffA); PG8_STAGE(PG8_SA(0, 1), cA + hstepA, voffA);
    if (wr == 1) PG8_BAR;
    PG8_WAIT_V(2); PG8_BAR;
    PG8_STAGE(PG8_SB(1, 0), cB + kstep, voffB); PG8_STAGE(PG8_SA(1, 0), cA + kstep, voffA); PG8_STAGE(PG8_SB(1, 1), cB + hstepB + kstep, voffB);
    PG8_WAIT_V(6); PG8_BAR;
    for (;;) {
        const bool has_next = S.next(ui + 1, nxt);
        const char* nA = has_next ? (const char*)g.A + (size_t)nxt.pm * tstep : cA; const char* nB = has_next ? (const char*)g.Bt + (size_t)nxt.pn * tstep : cB;
#pragma nounroll
        for (int t = 0; t < nt; t += 2) {
            const bool last = (t == nt - 2);
            const char* a1 = cA + (size_t)(t + 1) * kstep;
            const char* a2 = last ? nA : cA + (size_t)(t + 2) * kstep; const char* b2 = last ? nB : cB + (size_t)(t + 2) * kstep;
            const char* a3 = a2 + kstep; const char* b3 = b2 + kstep;
            if constexpr (Epi::MIDK) { if (t == (nt >> 1)) E.mid(acc, cur, ui, wr, wc, fr, fq); }
            const bool relax = (t == 0) && (ui > 0);
            PG8_LDB(B0, 0, 0); PG8_LDB(B1, 0, 1); PG8_SCHED; PG8_LDA(At, 0, 0); if (!relax) PG8_STAGE(PG8_SA(1, 1), a1 + hstepA, voffA);
            if (relax) PG8_WAIT_V(22); else PG8_WAIT_V(8);
            PG8_WAIT_L(0); PG8_BAR; PG8_MMA(0, 0, At, B0); PG8_MMA(0, 1, At, B1); PG8_BAR; PG8_SCHED;
            PG8_LDA(At, 0, 1); PG8_STAGE(PG8_SB(0, 0), b2, voffB); PG8_STAGE(PG8_SB(0, 1), b2 + hstepB, voffB); PG8_STAGE(PG8_SA(0, 0), a2, voffA);
            if (relax) PG8_WAIT_V(22); else PG8_WAIT_V(8);
            PG8_WAIT_L(0); PG8_BAR; PG8_MMA(1, 0, At, B0); PG8_MMA(1, 1, At, B1); PG8_BAR; PG8_SCHED;
            PG8_LDB(B0, 1, 0); PG8_LDB(B1, 1, 1); PG8_SCHED; PG8_LDA(At, 1, 0); PG8_STAGE(PG8_SA(0, 1), a2 + hstepA, voffA);
            if (relax) PG8_WAIT_V(22); else PG8_WAIT_V(8);
            PG8_WAIT_L(0); PG8_BAR; PG8_MMA(0, 0, At, B0); PG8_MMA(0, 1, At, B1); PG8_BAR; PG8_SCHED;
            PG8_LDA(At, 1, 1); PG8_STAGE(PG8_SB(1, 0), b3, voffB); PG8_STAGE(PG8_SB(1, 1), b3 + hstepB, voffB); PG8_STAGE(PG8_SA(1, 0), a3, voffA);
            PG8_WAIT_V(8); PG8_WAIT_L(0); PG8_BAR; PG8_MMA(1, 0, At, B0); PG8_MMA(1, 1, At, B1); PG8_BAR; PG8_SCHED;
        }
        if (has_next) PG8_STAGE(PG8_SA(1, 1), nA + kstep + hstepA, voffA);
        if (wr == 0) PG8_BAR;
        E(acc, cur, ui, wr, wc, fr, fq);
        if (!has_next) break;
#pragma unroll
        for (int a = 0; a < 2; ++a)
#pragma unroll
            for (int b = 0; b < 2; ++b)
#pragma unroll
                for (int m = 0; m < 4; ++m)
#pragma unroll
                    for (int n = 0; n < 2; ++n) acc[a][b][m][n] = (f32x4){0.f, 0.f, 0.f, 0.f};
        cur = nxt; cA = nA; cB = nB; ++ui;
        if (wr == 1) PG8_BAR;
    }
    PG8_WAIT_V(0);
    PG8_BAR;
#undef PG8_SA
#undef PG8_SB
#undef PG8_STAGE
#undef PG8_LDA
#undef PG8_LDB
#undef PG8_MMA
#undef PG8_WAIT_V
#undef PG8_WAIT_L
#undef PG8_BAR
#undef PG8_SCHED
}
}
using pg8::Unit;
typedef f32x4 AccT[2][2][4][2];

__device__ __forceinline__ void unpack8(const u32x4 w, f32x4& v0, f32x4& v1) {
    v0.x = bf_lo(w.x); v0.y = bf_hi(w.x); v0.z = bf_lo(w.y); v0.w = bf_hi(w.y); v1.x = bf_lo(w.z); v1.y = bf_hi(w.z); v1.z = bf_lo(w.w); v1.w = bf_hi(w.w);
}
__device__ __forceinline__ void store_x8(bf16_t* xb, size_t off, const f32x4 v0, const f32x4 v1, float& ssq) {
    u32x4 w; w.x = cvt_pk_bf16(v0.x, v0.y); w.y = cvt_pk_bf16(v0.z, v0.w); w.z = cvt_pk_bf16(v1.x, v1.y); w.w = cvt_pk_bf16(v1.z, v1.w);
    *(u32x4*)(xb + off) = w;
    ssq += ((v0.x * v0.x + v0.y * v0.y) + (v0.z * v0.z + v0.w * v0.w)) + ((v1.x * v1.x + v1.y * v1.y) + (v1.z * v1.z + v1.w * v1.w));
}

struct EpiWin {
    static constexpr bool ROWPERM = false, MIDK = false;
    const LAS float* tab; bf16_t* Z; float* vst;
    __device__ __forceinline__ void operator()(AccT& acc, const Unit& u, int ui, int wr, int wc, int fr, int fq) const {
        const int col0 = u.pn * 256 + 32 * wc + 8 * fq; const int sect = u.pn >> 2;
#pragma unroll
        for (int ai = 0; ai < 2; ++ai)
#pragma unroll
            for (int m = 0; m < 4; ++m) {
                const int row = pg8::epi_row<false>(u, ai, m, wr, fr);
                const float rs = tab[ui * 256 + (row & 255)];
                float s1 = 0.f, s2 = 0.f;
#pragma unroll
                for (int bj = 0; bj < 2; ++bj) {
                    f32x4 v0 = acc[ai][bj][m][0] * rs, v1 = acc[ai][bj][m][1] * rs;
                    if (sect < 2) {
#pragma unroll
                        for (int j = 0; j < 4; ++j) { v0[j] = gelu_tanh(v0[j]); v1[j] = gelu_tanh(v1[j]); }
                    }
                    if (sect == 1) {
                        s1 += ((v0.x + v0.y) + (v0.z + v0.w)) + ((v1.x + v1.y) + (v1.z + v1.w));
                        s2 += ((v0.x * v0.x + v0.y * v0.y) + (v0.z * v0.z + v0.w * v0.w)) + ((v1.x * v1.x + v1.y * v1.y) + (v1.z * v1.z + v1.w * v1.w));
                    }
                    u32x4 w; w.x = cvt_pk_bf16(v0.x, v0.y); w.y = cvt_pk_bf16(v0.z, v0.w); w.z = cvt_pk_bf16(v1.x, v1.y); w.w = cvt_pk_bf16(v1.z, v1.w);
                    *(u32x4*)(Z + (size_t)row * NZ + col0 + 128 * bj) = w;
                }
                if (sect == 1) {
                    s1 = red_fq(s1); s2 = red_fq(s2);
                    if (fq == 0) *(f32x2*)(vst + ((size_t)row * 16 + (u.pn - 4) * 4 + wc) * 2) = (f32x2){s1, s2};
                }
            }
    }
};

struct EpiGlu {
    static constexpr bool ROWPERM = false, MIDK = false;
    const bf16_t* ZS; const float* bias; bf16_t* MIXB; float* ybst;
    __device__ __forceinline__ void operator()(AccT& acc, const Unit& u, int ui, int wr, int wc, int fr, int fq) const {
        const int col0 = u.pn * 256 + 32 * wc + 8 * fq;
#pragma unroll
        for (int ai = 0; ai < 2; ++ai)
#pragma unroll
            for (int m = 0; m < 4; ++m) {
                const int row = pg8::epi_row<false>(u, ai, m, wr, fr);
                float ssq = 0.f;
#pragma unroll
                for (int bj = 0; bj < 2; ++bj) {
                    const int col = col0 + 128 * bj;
                    const u32x4 zz = *(const u32x4*)(ZS + (size_t)row * DS + col);
                    const f32x4 b0 = *(const f32x4*)(bias + col), b1 = *(const f32x4*)(bias + col + 4);
                    const f32x4 a0 = acc[ai][bj][m][0] + b0, a1 = acc[ai][bj][m][1] + b1;
                    float y[8];
                    y[0] = bf_lo(zz.x) * fast_sigmoid(a0.x); y[1] = bf_hi(zz.x) * fast_sigmoid(a0.y); y[2] = bf_lo(zz.y) * fast_sigmoid(a0.z); y[3] = bf_hi(zz.y) * fast_sigmoid(a0.w);
                    y[4] = bf_lo(zz.z) * fast_sigmoid(a1.x); y[5] = bf_hi(zz.z) * fast_sigmoid(a1.y); y[6] = bf_lo(zz.w) * fast_sigmoid(a1.z); y[7] = bf_hi(zz.w) * fast_sigmoid(a1.w);
#pragma unroll
                    for (int j = 0; j < 8; ++j) ssq += y[j] * y[j];
                    u32x4 w; w.x = cvt_pk_bf16(y[0], y[1]); w.y = cvt_pk_bf16(y[2], y[3]); w.z = cvt_pk_bf16(y[4], y[5]); w.w = cvt_pk_bf16(y[6], y[7]);
                    *(u32x4*)(MIXB + (size_t)row * DM + DS + col) = w;
                }
                ssq = red_fq(ssq);
                if (fq == 0) ybst[(size_t)row * 16 + u.pn * 4 + wc] = ssq;
            }
    }
};

struct EpiWout {
    static constexpr bool ROWPERM = false, MIDK = true;
    const LAS float* tab; bf16_t* X; float* stout;
    __device__ __forceinline__ void mid(AccT& acc, const Unit& u, int ui, int wr, int wc, int fr, int fq) const {
#pragma unroll
        for (int ai = 0; ai < 2; ++ai)
#pragma unroll
            for (int m = 0; m < 4; ++m) {
                const int row = pg8::epi_row<false>(u, ai, m, wr, fr);
                const float ratio = tab[ui * 256 + (row & 255)];
#pragma unroll
                for (int bj = 0; bj < 2; ++bj) { acc[ai][bj][m][0] *= ratio; acc[ai][bj][m][1] *= ratio; }
            }
    }
    __device__ __forceinline__ void operator()(AccT& acc, const Unit& u, int ui, int wr, int wc, int fr, int fq) const {
        const int col0 = u.pn * 256 + 32 * wc + 8 * fq;
#pragma unroll
        for (int ai = 0; ai < 2; ++ai) {
            u32x4 xr[4][2];
#pragma unroll
            for (int m = 0; m < 4; ++m)
#pragma unroll
                for (int bj = 0; bj < 2; ++bj) xr[m][bj] = *(const u32x4*)(X + (size_t)pg8::epi_row<false>(u, ai, m, wr, fr) * DM + col0 + 128 * bj);
#pragma unroll
            for (int m = 0; m < 4; ++m) {
                const int row = pg8::epi_row<false>(u, ai, m, wr, fr);
                const float rb = tab[1024 + ui * 256 + (row & 255)];
                float ssq = 0.f;
#pragma unroll
                for (int bj = 0; bj < 2; ++bj) {
                    f32x4 x0, x1; unpack8(xr[m][bj], x0, x1);
                    store_x8(X, (size_t)row * DM + col0 + 128 * bj, x0 + acc[ai][bj][m][0] * rb, x1 + acc[ai][bj][m][1] * rb, ssq);
                }
                ssq = red_fq(ssq);
                if (fq == 0) stout[(size_t)row * 32 + u.pn * 4 + wc] = ssq;
            }
        }
    }
};

struct EpiDown {
    static constexpr bool ROWPERM = false, MIDK = false;
    bf16_t* X; float* stout;
    __device__ __forceinline__ void operator()(AccT& acc, const Unit& u, int ui, int wr, int wc, int fr, int fq) const {
        const int col0 = u.pn * 256 + 32 * wc + 8 * fq;
#pragma unroll
        for (int ai = 0; ai < 2; ++ai) {
            u32x4 xr[4][2];
#pragma unroll
            for (int m = 0; m < 4; ++m)
#pragma unroll
                for (int bj = 0; bj < 2; ++bj) xr[m][bj] = *(const u32x4*)(X + (size_t)pg8::epi_row<false>(u, ai, m, wr, fr) * DM + col0 + 128 * bj);
#pragma unroll
            for (int m = 0; m < 4; ++m) {
                const int row = pg8::epi_row<false>(u, ai, m, wr, fr);
                float ssq = 0.f;
#pragma unroll
                for (int bj = 0; bj < 2; ++bj) {
                    f32x4 x0, x1; unpack8(xr[m][bj], x0, x1);
                    store_x8(X, (size_t)row * DM + col0 + 128 * bj, x0 + acc[ai][bj][m][0], x1 + acc[ai][bj][m][1], ssq);
                }
                ssq = red_fq(ssq);
                if (fq == 0) stout[(size_t)row * 32 + u.pn * 4 + wc] = ssq;
            }
        }
    }
};

struct EpiProj {
    static constexpr bool ROWPERM = false, MIDK = false;
    bf16_t* P;
    __device__ __forceinline__ void operator()(AccT& acc, const Unit& u, int ui, int wr, int wc, int fr, int fq) const {
        const int col0 = u.pn * 256 + 32 * wc + 8 * fq;
#pragma unroll
        for (int ai = 0; ai < 2; ++ai)
#pragma unroll
            for (int m = 0; m < 4; ++m) {
                const int row = pg8::epi_row<false>(u, ai, m, wr, fr);
#pragma unroll
                for (int bj = 0; bj < 2; ++bj) {
                    const f32x4 v0 = acc[ai][bj][m][0], v1 = acc[ai][bj][m][1];
                    u32x4 w; w.x = cvt_pk_bf16(v0.x, v0.y); w.y = cvt_pk_bf16(v0.z, v0.w); w.z = cvt_pk_bf16(v1.x, v1.y); w.w = cvt_pk_bf16(v1.z, v1.w);
                    *(u32x4*)(P + (size_t)row * DM + col0 + 128 * bj) = w;
                }
            }
    }
};

struct EpiGate {
    static constexpr bool ROWPERM = false, MIDK = false;
    const LAS float* tab; const bf16_t* XP; bf16_t* XQ; float* stout;
    __device__ __forceinline__ void operator()(AccT& acc, const Unit& u, int ui, int wr, int wc, int fr, int fq) const {
        const int col0 = u.pn * 256 + 32 * wc + 8 * fq;
#pragma unroll
        for (int ai = 0; ai < 2; ++ai) {
            u32x4 xr[4][2], pr[4][2];
#pragma unroll
            for (int m = 0; m < 4; ++m)
#pragma unroll
                for (int bj = 0; bj < 2; ++bj) { const size_t off = (size_t)pg8::epi_row<false>(u, ai, m, wr, fr) * DM + col0 + 128 * bj;
                    xr[m][bj] = *(const u32x4*)(XP + off); pr[m][bj] = *(const u32x4*)(XQ + off); }
#pragma unroll
            for (int m = 0; m < 4; ++m) {
                const int row = pg8::epi_row<false>(u, ai, m, wr, fr);
                const float rs = tab[ui * 256 + (row & 255)];
                float ssq = 0.f;
#pragma unroll
                for (int bj = 0; bj < 2; ++bj) {
                    f32x4 x0, x1, p0, p1; unpack8(xr[m][bj], x0, x1); unpack8(pr[m][bj], p0, p1);
                    const f32x4 a0 = acc[ai][bj][m][0] * rs, a1 = acc[ai][bj][m][1] * rs;
                    f32x4 n0, n1;
#pragma unroll
                    for (int e = 0; e < 4; ++e) { n0[e] = x0[e] + fast_sigmoid(a0[e]) * p0[e]; n1[e] = x1[e] + fast_sigmoid(a1[e]) * p1[e]; }
                    store_x8(XQ, (size_t)row * DM + col0 + 128 * bj, n0, n1, ssq);
                }
                ssq = red_fq(ssq);
                if (fq == 0) stout[(size_t)row * 32 + u.pn * 4 + wc] = ssq;
            }
        }
    }
};

struct EpiUp {
    static constexpr bool ROWPERM = true, MIDK = false;
    const LAS float* tab; const float* cw; const float* cb; bf16_t* HID; float* halo;
    __device__ __forceinline__ void conv_inplace(AccT& acc, int bj, int n, const float (&rs)[8], const float* cwp, const float* cbp, float* hp, int fr) const {
        const f32x4 w0 = *(const f32x4*)(cwp), w1 = *(const f32x4*)(cwp + NUP), w2 = *(const f32x4*)(cwp + 2 * NUP), bb = *(const f32x4*)(cbp);
#pragma unroll
        for (int j = 0; j < 8; ++j) acc[j >> 2][bj][j & 3][n] *= rs[j];
        f32x4 p1, p2;
#pragma unroll
        for (int e = 0; e < 4; ++e) { p1[e] = __shfl_up(acc[1][bj][3][n][e], 1, 16); p2[e] = __shfl_up(acc[1][bj][2][n][e], 1, 16); }
        if (fr == 0) { *(f32x4*)(hp) = acc[0][bj][0][n]; *(f32x4*)(hp + NUP) = acc[0][bj][1][n]; }
        if (fr == 15) { *(f32x4*)(hp + 2 * NUP) = acc[1][bj][2][n]; *(f32x4*)(hp + 3 * NUP) = acc[1][bj][3][n]; }
#pragma unroll
        for (int j = 7; j >= 0; --j) {
            const f32x4 m1 = (j >= 1) ? acc[(j - 1 >= 0 ? j - 1 : 0) >> 2][bj][(j - 1 >= 0 ? j - 1 : 0) & 3][n] : p1;
            const f32x4 m2 = (j >= 2) ? acc[(j - 2 >= 0 ? j - 2 : 0) >> 2][bj][(j - 2 >= 0 ? j - 2 : 0) & 3][n] : (j == 1 ? p1 : p2);
            acc[j >> 2][bj][j & 3][n] = w2 * acc[j >> 2][bj][j & 3][n] + (w1 * m1 + (w0 * m2 + bb));
        }
    }
    __device__ __forceinline__ void operator()(AccT& acc, const Unit& u, int ui, int wr, int wc, int fr, int fq) const {
        const int T0 = u.pm * 256 + 128 * wr + 8 * fr;
        const int G = u.pm * 2 + wr;
        const int tc0 = 32 * wc + 8 * fq;
        const int h0 = u.pn * 128 + tc0;
        float rs[8];
        { const LAS f32x4* tp = (const LAS f32x4*)(tab + ui * 256 + 128 * wr + 8 * fr); const f32x4 r0 = tp[0], r1 = tp[1];
          rs[0] = r0.x; rs[1] = r0.y; rs[2] = r0.z; rs[3] = r0.w; rs[4] = r1.x; rs[5] = r1.y; rs[6] = r1.z; rs[7] = r1.w; }
#pragma unroll
        for (int n = 0; n < 2; ++n) {
            const int hh = h0 + 4 * n;
            float* hp = halo + (size_t)G * 4 * NUP + (size_t)u.pn * 256 + tc0 + 4 * n;
            conv_inplace(acc, 0, n, rs, cw + hh, cb + hh, hp, fr);
            conv_inplace(acc, 1, n, rs, cw + FF + hh, cb + FF + hh, hp + 128, fr);
#pragma unroll
            for (int j = 0; j < 8; ++j) {
                const f32x4 cg_ = acc[j >> 2][0][j & 3][n], cu_ = acc[j >> 2][1][j & 3][n];
                f32x4 hv;
#pragma unroll
                for (int e = 0; e < 4; ++e) hv[e] = cg_[e] * fast_sigmoid(cg_[e]) * cu_[e];
                u32x2 w; w.x = cvt_pk_bf16(hv.x, hv.y); w.y = cvt_pk_bf16(hv.z, hv.w);
                *(u32x2*)(HID + (size_t)(T0 + j) * FF + hh) = w;
            }
        }
    }
};

struct Args { const float* in[29]; float* out; unsigned char* ws; int ph_lo, ph_hi; };

__device__ __forceinline__ void transpose_item(const float* W, int K, int N, const float* gk0, bf16_t* WT, int n0, int k0, int orow0, int lane) {
    const int kq = lane >> 4, nq = lane & 15;
    const float* src = W + (size_t)(k0 + 16 * kq) * N + n0 + 4 * nq;
    f32x4 v[16];
#pragma unroll
    for (int i = 0; i < 16; ++i) v[i] = *(const f32x4*)(src + (size_t)i * N);
    if (gk0) {
        const f32x4* gp = (const f32x4*)(gk0 + 16 * kq);
        const f32x4 g0 = gp[0], g1 = gp[1], g2 = gp[2], g3 = gp[3];
        v[0] *= g0.x; v[1] *= g0.y; v[2] *= g0.z; v[3] *= g0.w; v[4] *= g1.x; v[5] *= g1.y; v[6] *= g1.z; v[7] *= g1.w;
        v[8] *= g2.x; v[9] *= g2.y; v[10] *= g2.z; v[11] *= g2.w; v[12] *= g3.x; v[13] *= g3.y; v[14] *= g3.z; v[15] *= g3.w;
    }
#pragma unroll
    for (int e = 0; e < 4; ++e) {
        u32x4 o0, o1;
        o0.x = cvt_pk_bf16(v[0][e], v[1][e]); o0.y = cvt_pk_bf16(v[2][e], v[3][e]); o0.z = cvt_pk_bf16(v[4][e], v[5][e]); o0.w = cvt_pk_bf16(v[6][e], v[7][e]);
        o1.x = cvt_pk_bf16(v[8][e], v[9][e]); o1.y = cvt_pk_bf16(v[10][e], v[11][e]); o1.z = cvt_pk_bf16(v[12][e], v[13][e]); o1.w = cvt_pk_bf16(v[14][e], v[15][e]);
        bf16_t* dst = WT + (size_t)(orow0 + 4 * nq + e) * K + k0 + 16 * kq;
        *(u32x4*)dst = o0; *(u32x4*)(dst + 8) = o1;
    }
}

__device__ __forceinline__ double dsin_red(double r) {
    const double r2 = r * r; double term = r, s = r;
#pragma unroll 1
    for (int k = 1; k <= 14; ++k) { term *= -r2 / (double)((2 * k) * (2 * k + 1)); s += term; }
    return s;
}
__device__ __forceinline__ double dcos_red(double r) {
    const double r2 = r * r; double term = 1.0, s = 1.0;
#pragma unroll 1
    for (int k = 1; k <= 14; ++k) { term *= -r2 / (double)((2 * k - 1) * (2 * k)); s += term; }
    return s;
}
__device__ __forceinline__ double dexp_small(double x) {
    double term = 1.0, s = 1.0;
#pragma unroll 1
    for (int k = 1; k <= 16; ++k) { term *= x / (double)k; s += term; }
    return s;
}

__device__ __forceinline__ void prologue(const Args& a, unsigned char* lds_raw, const int g_wave) {
    unsigned char* ws = a.ws;
    int tid_ = THREAD_ID(); asm volatile("" : "+v"(tid_));
    const int tid = tid_, lane = tid & 63, wave = tid >> 6;
    const int G = gridDim.x, gw = blockIdx.x * 8 + wave, NGW = G * 8;
    const int gt = blockIdx.x * 512 + tid, NGT = G * 512;
    constexpr int I_IN = (DM / 64) * (NZ / 64), I_GLU = (DS / 64) * (DS / 64), I_OUT = (DM / 64) * (DM / 64), I_UP = (DM / 64) * (NUP / 64), I_DOWN = (FF / 64) * (DM / 64), I_GATE = (DM / 64) * (DM / 64), I_PROJ = (DP / 64) * (DM / 64);
    constexpr int I_LAYER = I_IN + I_GLU + I_OUT + I_UP + I_DOWN + I_GATE + I_PROJ;
    for (int it = gw; it < 2 * I_LAYER; it += NGW) {
        const int l = it / I_LAYER; int r = it % I_LAYER;
        unsigned char* wl = ws + WS_W + (size_t)l * W_LAYER;
        if (r < I_IN) { const int nblk = NZ / 64, kb = r / nblk, nb = r % nblk;
            transpose_item(a.in[3] + (size_t)l * DM * NZ, DM, NZ, a.in[2] + l * DM + kb * 64, (bf16_t*)(wl + W_IN), nb * 64, kb * 64, nb * 64, lane); continue; } r -= I_IN;
        if (r < I_GLU) { const int nblk = DS / 64, kb = r / nblk, nb = r % nblk;
            transpose_item(a.in[15] + (size_t)l * DS * DS, DS, DS, nullptr, (bf16_t*)(wl + W_GLU), nb * 64, kb * 64, nb * 64, lane); continue; } r -= I_GLU;
        if (r < I_OUT) { const int nblk = DM / 64, kb = r / nblk, nb = r % nblk; const int k0 = kb * 64;
            const float* gk = (k0 < DS) ? (a.in[17] + l * DS + k0) : (a.in[18] + l * DS + (k0 - DS));
            transpose_item(a.in[19] + (size_t)l * DM * DM, DM, DM, gk, (bf16_t*)(wl + W_OUT), nb * 64, k0, nb * 64, lane); continue; } r -= I_OUT;
        if (r < I_UP) { const int nblk = NUP / 64, kb = r / nblk, nb = r % nblk; const int n0 = nb * 64;
            const int bj = (n0 >= FF) ? 1 : 0, h = n0 - bj * FF, o0 = (h >> 7) * 256 + bj * 128 + (h & 127);
            transpose_item(a.in[21] + (size_t)l * DM * NUP, DM, NUP, a.in[20] + l * DM + kb * 64, (bf16_t*)(wl + W_UP), n0, kb * 64, o0, lane); continue; } r -= I_UP;
        if (r < I_DOWN) { const int nblk = DM / 64, kb = r / nblk, nb = r % nblk;
            transpose_item(a.in[24] + (size_t)l * FF * DM, FF, DM, nullptr, (bf16_t*)(wl + W_DOWN), nb * 64, kb * 64, nb * 64, lane); continue; } r -= I_DOWN;
        if (r < I_GATE) { const int nblk = DM / 64, kb = r / nblk, nb = r % nblk;
            transpose_item(a.in[26] + (size_t)l * DM * DM, DM, DM, a.in[25] + l * DM + kb * 64, (bf16_t*)(wl + W_GATE), nb * 64, kb * 64, nb * 64, lane); continue; } r -= I_GATE;
        { const int nblk = DM / 64, kb = r / nblk, nb = r % nblk;
            transpose_item(a.in[27] + (size_t)l * DP * DM, DP, DM, nullptr, (bf16_t*)(wl + W_PROJ), nb * 64, kb * 64, nb * 64, lane); }
    }
    {
        const float* x = a.in[0]; bf16_t* XB = (bf16_t*)(ws + WS_XB); float* st0 = (float*)(ws + WS_ST0);
        for (int row0 = gw; row0 < MTOK; row0 += 2 * NGW) {
            f32x4 v[2][8];
#pragma unroll
            for (int q = 0; q < 2; ++q) { const int row = (row0 + q * NGW < MTOK) ? row0 + q * NGW : row0; const f32x4* xr = (const f32x4*)(x + (size_t)row * DM) + lane;
#pragma unroll
                for (int j = 0; j < 8; ++j) v[q][j] = xr[64 * j]; }
#pragma unroll
            for (int q = 0; q < 2; ++q) { const int row = row0 + q * NGW; if (row >= MTOK) continue;
                float s = 0.f;
#pragma unroll
                for (int j = 0; j < 8; ++j) s += (v[q][j].x * v[q][j].x + v[q][j].y * v[q][j].y) + (v[q][j].z * v[q][j].z + v[q][j].w * v[q][j].w);
                s = wave_sum(s);
                u32x2* o = (u32x2*)(XB + (size_t)row * DM) + lane;
#pragma unroll
                for (int j = 0; j < 8; ++j) { u32x2 w; w.x = cvt_pk_bf16(v[q][j].x, v[q][j].y); w.y = cvt_pk_bf16(v[q][j].z, v[q][j].w); o[64 * j] = w; }
                if (lane < 32) st0[(size_t)row * 32 + lane] = (lane == 0) ? s : 0.f; }
        }
    }
    {
        const f32x4* p4 = (const f32x4*)a.in[1]; u32x2* o = (u32x2*)(ws + WS_PB);
        const int n4 = 2 * MTOK * DP / 4;
        for (int i0 = gt; i0 < n4; i0 += 8 * NGT) {
            f32x4 v[8];
#pragma unroll
            for (int j = 0; j < 8; ++j) { const int i = i0 + j * NGT; v[j] = (i < n4) ? p4[i] : (f32x4){0.f, 0.f, 0.f, 0.f}; }
#pragma unroll
            for (int j = 0; j < 8; ++j) { const int i = i0 + j * NGT; if (i < n4) { u32x2 w; w.x = cvt_pk_bf16(v[j].x, v[j].y); w.y = cvt_pk_bf16(v[j].z, v[j].w); o[i] = w; } }
        }
    }
    {
        const float* w = a.in[5]; bf16_t* o = (bf16_t*)(ws + WS_SGUW);
        for (int i = gt; i < 2 * 8 * 128 * 128; i += NGT) { const int s = i & 127, t = (i >> 7) & 127; const float v = (s <= t) ? w[i] : 0.f; o[i] = (bf16_t)(cvt_pk_bf16(v, 0.f) & 0xffffu); }
    }
    for (int i = gt; i < 2 * 64 * 64; i += NGT) {
        const int l = i >> 12, g = (i >> 6) & 63, n = i & 63;
        unsigned char* sp = ws + WS_S5P + (size_t)l * S5_LAYER;
        const double lr = (double)a.in[7][i], li = (double)a.in[8][i];
        const double dt = (double)expf(a.in[9][l * 64 + g]);
        const double mag = dexp_small(lr * dt);
        const double th = li * dt; const double kq = rint(th * 0.15915494309189533577); const double rr = th - kq * 6.283185307179586476925;
        const double abr = mag * dcos_red(rr), abi = mag * dsin_red(rr);
        const double den = lr * lr + li * li, nr = abr - 1.0;
        const double qr = (nr * lr + abi * li) / den, qi = (abi * lr - nr * li) / den;
        *(f32x2*)((float*)(sp + S5_AA) + ((size_t)g * 64 + n) * 2) = (f32x2){(float)abr, (float)abi};
        bf16_t* bc = (bf16_t*)(sp + S5_BCAT) + ((size_t)g * 128 + 2 * n) * 16;
        const float* bre = a.in[10] + (size_t)i * 16; const float* bim = a.in[11] + (size_t)i * 16;
#pragma unroll
        for (int c = 0; c < 16; c += 2) {
            const double r0 = bre[c], i0 = bim[c], r1 = bre[c + 1], i1 = bim[c + 1];
            *(unsigned*)(bc + c) = cvt_pk_bf16((float)(qr * r0 - qi * i0), (float)(qr * r1 - qi * i1));
            *(unsigned*)(bc + 16 + c) = cvt_pk_bf16((float)(qr * i0 + qi * r0), (float)(qr * i1 + qi * r1));
        }
        bf16_t* cm = (bf16_t*)(sp + S5_CMT) + (size_t)g * 16 * 128 + 2 * n;
        const float* cre = a.in[12] + ((size_t)(l * 64 + g) * 16) * 64 + n; const float* cim = a.in[13] + ((size_t)(l * 64 + g) * 16) * 64 + n;
#pragma unroll
        for (int c = 0; c < 16; ++c) *(unsigned*)(cm + c * 128) = cvt_pk_bf16(cre[c * 64], -cim[c * 64]);
    }
}

__device__ __forceinline__ void sgu_phase(const Args& a, int l, unsigned char* lds_raw, const int g_wave) {
    unsigned char* ws = a.ws;
    int tid_ = THREAD_ID(); asm volatile("" : "+v"(tid_));
    const int tid = tid_, lane = tid & 63, wid = tid >> 6, wr = wid >> 2, wc = wid & 3, fr = lane & 15, fq = lane >> 4;
    const bf16_t* Z = (const bf16_t*)(ws + WS_Z); bf16_t* MIX = (bf16_t*)(ws + WS_MIX);
    const float* vst = (const float*)(ws + WS_VST); float* yast = (float*)(ws + WS_YAST);
    const float* gsgu = a.in[4] + l * DS; const float* sb = a.in[6] + l * 8 * 128;
    const bf16_t* Wm = (const bf16_t*)(ws + WS_SGUW) + (size_t)l * 8 * 128 * 128;
    float* stat = (float*)lds_raw;
    bf16_t* vT0 = (bf16_t*)(lds_raw + 1024);
#define SGU_LOAD_V(hv, VV) do { const bf16_t* Zh = Z + 128 * (hv); \
        _Pragma("unroll") for (int i = 0; i < 4; ++i) VV[i] = *(const u32x4*)(Zh + DS + lnd(zvo[i])); } while (0)
#define SGU_LOAD_U(hv, UU, BI) do { const int h_ = (hv); const bf16_t* Zh = Z + 128 * h_; const float* sbh = sb + 128 * h_; \
        _Pragma("unroll") for (int m = 0; m < 4; ++m) { BI[m] = sbh[64 * wr + 16 * m + fr]; \
            _Pragma("unroll") for (int n = 0; n < 2; ++n) UU[m][n] = *(const u32x2*)(Zh + lnd(zuo[m]) + 16 * n); } } while (0)
#define SGU_LOAD_AF(hv) do { const bf16_t* Wh = Wm + (size_t)(hv) * 128 * 128; \
        _Pragma("unroll") for (int k = 0; k < 4; ++k) _Pragma("unroll") for (int m = 0; m < 4; ++m) af[k][m] = *(const bf16x8*)(Wh + lnd(wao) + 16 * 128 * m + 32 * k); } while (0)
#define SGU_STAGE(hv, VV, bufv) do { const int h_ = (hv); bf16_t* vT = vT0 + (bufv) * (128 * 136); const float* gh = gsgu + 128 * h_; \
        _Pragma("unroll") for (int i = 0; i < 4; ++i) { const int idx = tid + 512 * i, s = idx >> 4, c8 = idx & 15; \
            const float mean = stat[2 * s], rstd = stat[2 * s + 1]; \
            const f32x4 g0 = *(const f32x4*)(gh + 8 * c8), g1 = *(const f32x4*)(gh + 8 * c8 + 4); \
            float e[8]; \
            e[0] = (bf_lo(VV[i].x) - mean) * rstd * g0.x; e[1] = (bf_hi(VV[i].x) - mean) * rstd * g0.y; e[2] = (bf_lo(VV[i].y) - mean) * rstd * g0.z; e[3] = (bf_hi(VV[i].y) - mean) * rstd * g0.w; \
            e[4] = (bf_lo(VV[i].z) - mean) * rstd * g1.x; e[5] = (bf_hi(VV[i].z) - mean) * rstd * g1.y; e[6] = (bf_lo(VV[i].w) - mean) * rstd * g1.z; e[7] = (bf_hi(VV[i].w) - mean) * rstd * g1.w; \
            _Pragma("unroll") for (int j = 0; j < 8; ++j) vT[(8 * c8 + j) * 136 + (s ^ (c8 << 3))] = (bf16_t)(cvt_pk_bf16(e[j], 0.f) & 0xffffu); } } while (0)
#define SGU_MMA(bufv) do { const bf16_t* vT = vT0 + (bufv) * (128 * 136); \
        _Pragma("unroll") for (int m = 0; m < 4; ++m) { acc[m][0] = (f32x4){0.f, 0.f, 0.f, 0.f}; acc[m][1] = (f32x4){0.f, 0.f, 0.f, 0.f}; } \
        _Pragma("unroll") for (int k = 0; k < 4; ++k) { bf16x8 bf[2]; \
            _Pragma("unroll") for (int n = 0; n < 2; ++n) bf[n] = *(const bf16x8*)(vT + (32 * wc + 16 * n + fr) * 136 + 8 * ((4 * k + fq) ^ (((32 * wc + 16 * n + fr) >> 3) & 15))); \
            _Pragma("unroll") for (int m = 0; m < 4; ++m) _Pragma("unroll") for (int n = 0; n < 2; ++n) acc[m][n] = __builtin_amdgcn_mfma_f32_16x16x32_bf16(bf[n], af[k][m], acc[m][n], 0, 0, 0); } } while (0)
#define SGU_EPI(hv, UU, BI) do { const int h_ = (hv); bf16_t* Mh = MIX + 128 * h_; float* yh = yast + 4 * h_; \
        _Pragma("unroll") for (int m = 0; m < 4; ++m) { float ssq = 0.f; \
            _Pragma("unroll") for (int n = 0; n < 2; ++n) { const f32x4 q = acc[m][n] + BI[m]; \
                const float y0 = bf_lo(UU[m][n].x) * q.x, y1 = bf_hi(UU[m][n].x) * q.y, y2 = bf_lo(UU[m][n].y) * q.z, y3 = bf_hi(UU[m][n].y) * q.w; \
                ssq += (y0 * y0 + y1 * y1) + (y2 * y2 + y3 * y3); \
                u32x2 w; w.x = cvt_pk_bf16(y0, y1); w.y = cvt_pk_bf16(y2, y3); *(u32x2*)(Mh + lnd(mxo) + (unsigned)(16 * m) * DM + 16 * n) = w; } \
            ssq = red_fq(ssq); if (fq == 0) yh[lnd(yso) + 16 * 32 * m] = ssq; } } while (0)
    for (int chunk = blockIdx.x; chunk < MTOK / 128; chunk += gridDim.x) {
        const int T0 = chunk * 128;
        unsigned zvo[4], zuo[4];
#pragma unroll
        for (int i = 0; i < 4; ++i) { const int idx = tid + 512 * i, s_ = idx >> 4, c8 = idx & 15; zvo[i] = (unsigned)(T0 + s_) * NZ + 8 * c8; }
#pragma unroll
        for (int m = 0; m < 4; ++m) zuo[m] = (unsigned)(T0 + 64 * wr + 16 * m + fr) * NZ + 32 * wc + 4 * fq;
        const unsigned wao = (unsigned)(64 * wr + fr) * 128 + 8 * fq;
        const unsigned mxo = (unsigned)(T0 + 64 * wr + fr) * DM + 32 * wc + 4 * fq;
        const unsigned yso = (unsigned)(T0 + 64 * wr + fr) * 32 + wc;
        u32x4 vvA[4], vvB[4]; u32x2 uu[4][2]; float bi[4]; bf16x8 af[4][4]; f32x4 acc[4][2];
        SGU_LOAD_V(0, vvA); SGU_LOAD_AF(0); SGU_LOAD_U(0, uu, bi);
        __syncthreads();
        if (tid < 128) {
            const f32x4* p = (const f32x4*)(vst + (size_t)(T0 + tid) * 32);
            float s1 = 0.f, s2 = 0.f;
#pragma unroll
            for (int j = 0; j < 8; ++j) { const f32x4 q = p[j]; s1 += q.x + q.z; s2 += q.y + q.w; }
            const float mean = s1 * (1.0f / DS); const float var = s2 * (1.0f / DS) - mean * mean;
            stat[2 * tid] = mean; stat[2 * tid + 1] = __builtin_amdgcn_rsqf(fmaxf(var, 0.f) + EPS);
        }
        __syncthreads();
#pragma nounroll
        for (int h = 0; h < 8; h += 2) {
            const int h2 = (h + 2 < 8) ? h + 2 : 7;
            SGU_LOAD_V(h + 1, vvB);
            SGU_STAGE(h, vvA, 0); __syncthreads(); SGU_MMA(0); SGU_LOAD_AF(h + 1); SGU_EPI(h, uu, bi); SGU_LOAD_U(h + 1, uu, bi);
            SGU_LOAD_V(h2, vvA);
            SGU_STAGE(h + 1, vvB, 1); __syncthreads(); SGU_MMA(1); SGU_LOAD_AF(h2); SGU_EPI(h + 1, uu, bi); SGU_LOAD_U(h2, uu, bi);
        }
    }
#undef SGU_LOAD_V
#undef SGU_LOAD_U
#undef SGU_LOAD_AF
#undef SGU_STAGE
#undef SGU_MMA
#undef SGU_EPI
}

__device__ __forceinline__ void s5_phase(const Args& a, int l, unsigned char* lds_raw, const int g_wave) {
    unsigned char* ws = a.ws;
    int tid_ = THREAD_ID(); asm volatile("" : "+v"(tid_));
    const int tid = tid_, lane = tid & 63, wid = __builtin_amdgcn_readfirstlane(tid >> 6), fr = lane & 15, fq = lane >> 4;
    const bf16_t* Z = (const bf16_t*)(ws + WS_Z); bf16_t* ZS = (bf16_t*)(ws + WS_ZS);
    const unsigned char* sp = ws + WS_S5P + (size_t)l * S5_LAYER;
    const bf16_t* Bcat = (const bf16_t*)(sp + S5_BCAT); const bf16_t* CmT = (const bf16_t*)(sp + S5_CMT); const float* AA = (const float*)(sp + S5_AA);
    const float* dvec = a.in[14] + l * DS;
    constexpr int TC = 32, NCH = SEQ / TC;
    bf16_t* BUb = (bf16_t*)lds_raw;
    bf16_t* H = (bf16_t*)(lds_raw + 2 * 4 * TC * 136 * 2);
    const bf16x8 zero8 = (bf16x8){0, 0, 0, 0, 0, 0, 0, 0};
    for (int item = blockIdx.x; item < 256; item += gridDim.x) {
        const int b = item >> 4, gq = ((item & 15) + b) & 15;
        __syncthreads();
        if (wid < 4) {
            const f32x2 aa = *(const f32x2*)(AA + ((size_t)(4 * gq + wid) * 64 + lane) * 2);
            const float ar = aa.x, ai = aa.y, nai = -aa.y; float hr = 0.f, hi = 0.f;
#pragma nounroll
            for (int s = 0; s < NCH + 2; ++s) {
                if (s >= 1 && s <= NCH) {
                    const int ch = s - 1;
                    const unsigned* bu = (const unsigned*)(BUb + (size_t)(((ch & 1) * 4 + wid) * TC) * 136) + lane;
                    unsigned* hw = (unsigned*)(H + (size_t)(((ch & 1) * 4 + wid) * TC) * 136) + lane;
                    unsigned v[TC];
#pragma unroll
                    for (int t = 0; t < TC; ++t) v[t] = bu[t * 68];
#pragma unroll
                    for (int t = 0; t < TC; ++t) {
                        const float re = bf_lo(v[t]), im = bf_hi(v[t]); float tr, ti, nr, ni;
                        asm("v_fma_f32 %0, %1, %2, %3" : "=v"(tr) : "v"(nai), "v"(hi), "v"(re));
                        asm("v_fma_f32 %0, %1, %2, %3" : "=v"(ti) : "v"(ai), "v"(hr), "v"(im));
                        asm("v_fma_f32 %0, %1, %2, %3" : "=v"(nr) : "v"(ar), "v"(hr), "v"(tr));
                        asm("v_fma_f32 %0, %1, %2, %3" : "=v"(ni) : "v"(ar), "v"(hi), "v"(ti));
                        hr = nr; hi = ni;
                        hw[t * 68] = cvt_pk_bf16(hr, hi);
                    }
                }
                __syncthreads();
            }
        } else {
            const int gi = wid - 4, g = 4 * gq + gi;
            bf16x8 Bf[8], Cf[4];
#pragma unroll
            for (int nt = 0; nt < 8; ++nt) Bf[nt] = (fq < 2) ? *(const bf16x8*)(Bcat + ((size_t)g * 128 + 16 * nt + fr) * 16 + 8 * fq) : zero8;
#pragma unroll
            for (int k = 0; k < 4; ++k) Cf[k] = *(const bf16x8*)(CmT + ((size_t)g * 16 + fr) * 128 + 32 * k + 8 * fq);
            const f32x4 dv = *(const f32x4*)(dvec + 16 * g + 4 * fq);
            const bf16_t* zx = Z + ((size_t)b * SEQ + fr) * NZ + 2 * DS + 16 * g;
            bf16_t* zo = ZS + ((size_t)b * SEQ + fr) * DS + 16 * g + 4 * fq;
#define S5_LDF(c, mt) (*(const bf16x8*)(zx + (size_t)((c) * TC + 16 * (mt)) * NZ + 8 * (fq & 1)))
#define S5_LDY(c, mt) (*(const u32x2*)(zx + (size_t)((c) * TC + 16 * (mt)) * NZ + 4 * fq))
#define S5_BU1(sv, mt, XFv) do { const bf16x8 xz = (fq < 2) ? XFv : zero8; bf16_t* bw = BUb + (size_t)(((((sv) & 1) * 4 + gi) * TC) + 16 * (mt) + fr) * 136 + 4 * fq; \
        _Pragma("unroll") for (int nt = 0; nt < 8; ++nt) { const f32x4 r = __builtin_amdgcn_mfma_f32_16x16x32_bf16(Bf[nt], xz, (f32x4){0.f, 0.f, 0.f, 0.f}, 0, 0, 0); \
            u32x2 pk; pk.x = cvt_pk_bf16(r.x, r.y); pk.y = cvt_pk_bf16(r.z, r.w); *(u32x2*)(bw + 16 * nt) = pk; } } while (0)
#define S5_Y1(chv, mt, XYv) do { const int ch = (chv); f32x4 y = (f32x4){0.f, 0.f, 0.f, 0.f}; const bf16_t* hrow = H + (size_t)((((ch & 1) * 4 + gi) * TC) + 16 * (mt) + fr) * 136 + 8 * fq; \
        _Pragma("unroll") for (int k = 0; k < 4; ++k) { const bf16x8 hf = *(const bf16x8*)(hrow + 32 * k); y = __builtin_amdgcn_mfma_f32_16x16x32_bf16(Cf[k], hf, y, 0, 0, 0); } \
        const float y0 = y.x + dv.x * bf_lo(XYv.x), y1 = y.y + dv.y * bf_hi(XYv.x), y2 = y.z + dv.z * bf_lo(XYv.y), y3 = y.w + dv.w * bf_hi(XYv.y); \
        u32x2 w; w.x = cvt_pk_bf16(gelu_tanh(y0), gelu_tanh(y1)); w.y = cvt_pk_bf16(gelu_tanh(y2), gelu_tanh(y3)); \
        *(u32x2*)(zo + (size_t)(ch * TC + 16 * (mt)) * DS) = w; } while (0)
            bf16x8 XF0a = S5_LDF(0, 0), XF0b = S5_LDF(0, 1), XF1a = S5_LDF(1, 0), XF1b = S5_LDF(1, 1), XF2a = S5_LDF(2, 0), XF2b = S5_LDF(2, 1), XF3a = S5_LDF(3, 0), XF3b = S5_LDF(3, 1);
            u32x2 XY0a = S5_LDY(0, 0), XY0b = S5_LDY(0, 1), XY1a = S5_LDY(1, 0), XY1b = S5_LDY(1, 1), XY2a = S5_LDY(2, 0), XY2b = S5_LDY(2, 1), XY3a = S5_LDY(3, 0), XY3b = S5_LDY(3, 1);
#define S5_CL(c) (((c) < NCH) ? (c) : NCH - 1)
#define S5_STEP_BU(sv, XFa, XFb) do { S5_BU1(sv, 0, XFa); S5_BU1(sv, 1, XFb); XFa = S5_LDF(S5_CL((sv) + 4), 0); XFb = S5_LDF(S5_CL((sv) + 4), 1); } while (0)
#define S5_STEP_Y(sv, XYa, XYb) do { S5_Y1((sv) - 2, 0, XYa); S5_Y1((sv) - 2, 1, XYb); XYa = S5_LDY(S5_CL((sv) + 2), 0); XYb = S5_LDY(S5_CL((sv) + 2), 1); } while (0)
            S5_STEP_BU(0, XF0a, XF0b); __syncthreads();
            S5_STEP_BU(1, XF1a, XF1b); __syncthreads();
            S5_STEP_BU(2, XF2a, XF2b); S5_STEP_Y(2, XY0a, XY0b); __syncthreads();
            S5_STEP_BU(3, XF3a, XF3b); S5_STEP_Y(3, XY1a, XY1b); __syncthreads();
#pragma nounroll
            for (int s = 4; s < NCH; s += 4) {
                S5_STEP_BU(s, XF0a, XF0b); S5_STEP_Y(s, XY2a, XY2b); __syncthreads();
                S5_STEP_BU(s + 1, XF1a, XF1b); S5_STEP_Y(s + 1, XY3a, XY3b); __syncthreads();
                S5_STEP_BU(s + 2, XF2a, XF2b); S5_STEP_Y(s + 2, XY0a, XY0b); __syncthreads();
                S5_STEP_BU(s + 3, XF3a, XF3b); S5_STEP_Y(s + 3, XY1a, XY1b); __syncthreads();
            }
            S5_Y1(NCH - 2, 0, XY2a); S5_Y1(NCH - 2, 1, XY2b); __syncthreads();
            S5_Y1(NCH - 1, 0, XY3a); S5_Y1(NCH - 1, 1, XY3b); __syncthreads();
#undef S5_CL
#undef S5_STEP_BU
#undef S5_STEP_Y
#undef S5_BU1
#undef S5_Y1
#undef S5_LDF
#undef S5_LDY
        }
    }
    __syncthreads();
}

__device__ __forceinline__ void fixup_phase(const Args& a, int l, const pg8::StaticOrder& S, const int g_wave) {
    unsigned char* ws = a.ws;
    const float* halo = (const float*)(ws + WS_HALO); bf16_t* HID = (bf16_t*)(ws + WS_HID);
    const float* cw = a.in[22] + (size_t)l * 3 * NUP; const float* cb = a.in[23] + (size_t)l * NUP;
    int tid_ = THREAD_ID(); asm volatile("" : "+v"(tid_));
    constexpr int NQ = FF / 4;
    Unit u; int last_pm = -1;
    for (int ui = 0; S.next(ui, u); ++ui) {
      if (u.pm == last_pm) continue;
      last_pm = u.pm;
      for (int q = tid_; q < NQ; q += 512) {
        const int h = 4 * q, pn = h >> 7, tcg = pn * 256 + (h & 127), tcu = tcg + 128;
        const f32x4 w0g = *(const f32x4*)(cw + h), w1g = *(const f32x4*)(cw + NUP + h), w2g = *(const f32x4*)(cw + 2 * NUP + h), bg = *(const f32x4*)(cb + h);
        const f32x4 w0u = *(const f32x4*)(cw + FF + h), w1u = *(const f32x4*)(cw + NUP + FF + h), w2u = *(const f32x4*)(cw + 2 * NUP + FF + h), bu = *(const f32x4*)(cb + FF + h);
        f32x4 a0g[2], a1g[2], p2g[2], p3g[2], a0u[2], a1u[2], p2u[2], p3u[2];
#pragma unroll
        for (int gi = 0; gi < 2; ++gi) {
            const int G = 2 * u.pm + gi; const bool first = (G & 15) == 0;
            const float* hg = halo + (size_t)G * 4 * NUP; const float* hp = first ? hg : hg - (size_t)4 * NUP;
            a0g[gi] = *(const f32x4*)(hg + tcg); a0u[gi] = *(const f32x4*)(hg + tcu);
            a1g[gi] = *(const f32x4*)(hg + NUP + tcg); a1u[gi] = *(const f32x4*)(hg + NUP + tcu);
            p2g[gi] = *(const f32x4*)(hp + 2 * NUP + tcg); p2u[gi] = *(const f32x4*)(hp + 2 * NUP + tcu);
            p3g[gi] = *(const f32x4*)(hp + 3 * NUP + tcg); p3u[gi] = *(const f32x4*)(hp + 3 * NUP + tcu);
        }
#pragma unroll
        for (int gi = 0; gi < 2; ++gi) {
            const int G = 2 * u.pm + gi; const bool first = (G & 15) == 0;
            const f32x4 z4 = (f32x4){0.f, 0.f, 0.f, 0.f};
            const f32x4 q2g = first ? z4 : p2g[gi], q3g = first ? z4 : p3g[gi], q2u = first ? z4 : p2u[gi], q3u = first ? z4 : p3u[gi];
#pragma unroll
            for (int ri = 0; ri < 2; ++ri) {
                const f32x4 g2 = ri ? a1g[gi] : a0g[gi], g1 = ri ? a0g[gi] : q3g, g0 = ri ? q3g : q2g;
                const f32x4 u2 = ri ? a1u[gi] : a0u[gi], u1 = ri ? a0u[gi] : q3u, u0 = ri ? q3u : q2u;
                const f32x4 cg_ = w2g * g2 + (w1g * g1 + (w0g * g0 + bg)), cu_ = w2u * u2 + (w1u * u1 + (w0u * u0 + bu));
                f32x4 hv;
#pragma unroll
                for (int e = 0; e < 4; ++e) hv[e] = cg_[e] * fast_sigmoid(cg_[e]) * cu_[e];
                u32x2 w; w.x = cvt_pk_bf16(hv.x, hv.y); w.y = cvt_pk_bf16(hv.z, hv.w);
                *(u32x2*)(HID + (size_t)(G * 128 + ri) * FF + h) = w;
            }
        }
      }
    }
    asm volatile("s_waitcnt vmcnt(0)" ::: "memory");
    __syncthreads();
}

__device__ __forceinline__ void final_phase(const Args& a, const float* st, const bf16_t* X, const int g_wave) {
    int tid_ = THREAD_ID(); asm volatile("" : "+v"(tid_));
    const int lane = tid_ & 63, wave = tid_ >> 6;
    const int gw = blockIdx.x * 8 + wave, NGW = gridDim.x * 8;
    const float* gf = a.in[28];
    f32x4 g0[4], g1[4];
#pragma unroll
    for (int j = 0; j < 4; ++j) { g0[j] = *(const f32x4*)(gf + 512 * j + 8 * lane); g1[j] = *(const f32x4*)(gf + 512 * j + 8 * lane + 4); }
    for (int row0 = gw; row0 < MTOK; row0 += 4 * NGW) {
        float s[4]; u32x4 xv[4][4];
#pragma unroll
        for (int q = 0; q < 4; ++q) { const int row = row0 + q * NGW; const bool ok = row < MTOK; const int r = ok ? row : row0;
            s[q] = (lane < 32) ? st[(size_t)r * 32 + lane] : 0.f;
            const u32x4* xr = (const u32x4*)(X + (size_t)r * DM) + lane;
#pragma unroll
            for (int j = 0; j < 4; ++j) xv[q][j] = xr[64 * j]; }
#pragma unroll
        for (int q = 0; q < 4; ++q) { const int row = row0 + q * NGW; if (row >= MTOK) continue;
            const float rs = __builtin_amdgcn_rsqf(wave_sum(s[q]) * (1.0f / DM) + EPS);
            float* orow = a.out + (size_t)row * DM + 8 * lane;
#pragma unroll
            for (int j = 0; j < 4; ++j) { f32x4 v0, v1; unpack8(xv[q][j], v0, v1);
                *(f32x4*)(orow + 512 * j) = v0 * rs * g0[j]; *(f32x4*)(orow + 512 * j + 4) = v1 * rs * g1[j]; } }
    }
}

template <int MODE> __device__ __forceinline__ void fill_tab(float* tab, const pg8::StaticOrder& S, const float* st, const float* st2, const int g_wave) {
    int tid_ = THREAD_ID(); asm volatile("" : "+v"(tid_));
    constexpr int NB = (MODE == 0) ? 4 : 2;
    for (int base = tid_; ; base += NB * 512) {
        Unit u; int row[NB]; bool ok[NB]; f32x4 p[NB][8]; f32x4 q[NB][4];
#pragma unroll
        for (int b = 0; b < NB; ++b) { const int idx = base + b * 512; ok[b] = S.next(idx >> 8, u); row[b] = ok[b] ? u.pm * 256 + (idx & 255) : 0;
            const f32x4* sp = (const f32x4*)(st + (size_t)row[b] * 32);
#pragma unroll
            for (int j = 0; j < 8; ++j) p[b][j] = sp[j];
            if (MODE == 1) { const f32x4* sq = (const f32x4*)(st2 + (size_t)row[b] * 16);
#pragma unroll
                for (int j = 0; j < 4; ++j) q[b][j] = sq[j]; } }
        if (!ok[0]) break;
#pragma unroll
        for (int b = 0; b < NB; ++b) { if (!ok[b]) continue; const int idx = base + b * 512;
            float s = 0.f;
#pragma unroll
            for (int j = 0; j < 8; ++j) s += (p[b][j].x + p[b][j].y) + (p[b][j].z + p[b][j].w);
            if (MODE == 0) tab[idx] = __builtin_amdgcn_rsqf(s * (1.0f / DM) + EPS);
            else { float s2 = 0.f;
#pragma unroll
                for (int j = 0; j < 4; ++j) s2 += (q[b][j].x + q[b][j].y) + (q[b][j].z + q[b][j].w);
                const float ra = __builtin_amdgcn_rsqf(s * (1.0f / DS) + EPS), rb = __builtin_amdgcn_rsqf(s2 * (1.0f / DS) + EPS);
                tab[idx] = ra / rb; tab[1024 + idx] = rb; } }
    }
    __syncthreads();
}

#define XB_TMO      128
#define XB_XCNT(j)  (256  + 64 * (j))
#define XB_XSUB(j)  (1280 + 64 * (j))
#define XB_XGEN(j)  (2304 + 64 * (j))
#define XB_TOP      3328
#define XB_TOPGEN   3392
#define XCD_BAR_WORDS 3456
#define XB_SPIN_CAP (1u << 18)
__device__ __forceinline__ unsigned xb_ld(unsigned* p)              { return __hip_atomic_load(p, __ATOMIC_RELAXED, __HIP_MEMORY_SCOPE_AGENT); }
__device__ __forceinline__ unsigned xb_add(unsigned* p, unsigned v) { return __hip_atomic_fetch_add(p, v, __ATOMIC_RELAXED, __HIP_MEMORY_SCOPE_AGENT); }
__device__ __forceinline__ unsigned xb_xcc_id() { return (unsigned)__builtin_amdgcn_s_getreg((3 << 11) | 20) & 0xFu; }
#define XB_SPIN(cond, bar) do { unsigned _sp = 0; while (cond) { __builtin_amdgcn_s_sleep(1); \
    if ((++_sp & 255u) == 0u) { if (xb_ld(&(bar)[XB_TMO])) break; if (_sp > XB_SPIN_CAP) { atomicAdd(&(bar)[XB_TMO], 1u); break; } } } } while (0)
struct XcdBarrier { unsigned* bar; unsigned x; volatile LAS unsigned* st; };
__device__ __forceinline__ XcdBarrier xcd_barrier_post(unsigned* bar, volatile LAS unsigned* st, const int g_wave) {
    XcdBarrier b; b.bar = bar; b.x = xb_xcc_id(); b.st = st;
    if (THREAD_ID() == 0) (void)xb_add(&bar[XB_XCNT(b.x)], 1u);
    return b;
}
__device__ __forceinline__ void xcd_barrier_complete(unsigned* bar, unsigned x, unsigned& nloc, unsigned& nx) {
    const unsigned G = gridDim.x * gridDim.y * gridDim.z;
    unsigned sum, cnt, mine, sp = 0u;
    for (;;) {
        sum = 0u; cnt = 0u; mine = 0u;
#pragma unroll
        for (unsigned j = 0; j < 16; ++j) { const unsigned c = xb_ld(&bar[XB_XCNT(j)]); sum += c; cnt += (c > 0u) ? 1u : 0u; mine = (j == x) ? c : mine; }
        if (sum == G) break;
        __builtin_amdgcn_s_sleep(1);
        if ((++sp & 255u) == 0u) { if (xb_ld(&bar[XB_TMO])) break; if (sp > XB_SPIN_CAP) { atomicAdd(&bar[XB_TMO], 1u); break; } }
    }
    nloc = mine > 0u ? mine : 1u; nx = cnt > 0u ? cnt : 1u;
}
__device__ __forceinline__ void xcd_barrier(const XcdBarrier& b, const int g_wave) {
    asm volatile("s_waitcnt vmcnt(0)" ::: "memory");
    __syncthreads();
    if (THREAD_ID() == 0) {
        unsigned* bar = b.bar;
        __builtin_amdgcn_s_waitcnt(0);
        unsigned nloc = b.st[0], nx = b.st[1];
        if (nloc == 0u) { xcd_barrier_complete(bar, b.x, nloc, nx); b.st[0] = nloc; b.st[1] = nx; }
        const unsigned old = xb_add(&bar[XB_XSUB(b.x)], 1u);
        const unsigned gen = old / nloc;
        if (old + 1u == (gen + 1u) * nloc) {
            __builtin_amdgcn_fence(__ATOMIC_RELEASE, "agent");
            asm volatile("s_waitcnt vmcnt(0)" ::: "memory");
            const unsigned og = xb_add(&bar[XB_TOP], 1u);
            const unsigned tg = og / nx;
            if (og + 1u == (tg + 1u) * nx) xb_add(&bar[XB_TOPGEN], 1u);
            else XB_SPIN(xb_ld(&bar[XB_TOPGEN]) == tg, bar);
            __builtin_amdgcn_fence(__ATOMIC_ACQUIRE, "agent");
            xb_add(&bar[XB_XGEN(b.x)], 1u);
            asm volatile("s_waitcnt vmcnt(0)" ::: "memory");
        } else {
            XB_SPIN(xb_ld(&bar[XB_XGEN(b.x)]) == gen, bar);
            __builtin_amdgcn_fence(__ATOMIC_ACQUIRE, "agent");
            asm volatile("s_waitcnt vmcnt(0)" ::: "memory");
        }
    }
    __syncthreads();
}

__global__ void __launch_bounds__(512, 2) fwd_kernel(Args a0) {
    extern __shared__ __attribute__((aligned(16))) unsigned char lds_raw[];
    LAS unsigned char* lds = (LAS unsigned char*)lds_raw;
    cg::grid_group grid = cg::this_grid();
    float* tabg = (float*)(lds_raw + LDS_RING); const LAS float* tabl = (const LAS float*)(lds + LDS_RING);
    const int ph_hi = a0.ph_hi;
    const int g_wave = __builtin_amdgcn_readfirstlane((int)threadIdx.x >> 6);
    if (THREAD_ID() < 16) ((volatile LAS unsigned*)(lds + LDS_MISC))[THREAD_ID()] = 0u;
    __syncthreads();
    (void)xcd_barrier_post((unsigned*)(a0.ws + WS_CTL), (volatile LAS unsigned*)(lds + LDS_MISC), g_wave);
#pragma nounroll
    for (int ph = a0.ph_lo; ph < ph_hi; ++ph) {
#if defined(__HIP_DEVICE_COMPILE__)
        const __attribute__((address_space(4))) Args* ap = (const __attribute__((address_space(4))) Args*)__builtin_amdgcn_kernarg_segment_ptr();
        asm volatile("" : "+s"(ap));
        Args a;
#pragma unroll
        for (int i = 0; i < 29; ++i) a.in[i] = ap->in[i];
        a.out = ap->out; a.ws = ap->ws; a.ph_lo = 0; a.ph_hi = 0;
#else
        const Args a = a0;
#endif
        unsigned char* ws = a.ws;
        int G = gridDim.x, cblk = blockIdx.x; asm volatile("" : "+s"(G), "+s"(cblk));
        if (ph == 0) {
            if constexpr (PHON(8)) for (int rep = 0; rep < DUPN(8); ++rep) { prologue(a, lds_raw, g_wave); __syncthreads(); }
        } else if (ph == 15) {
            if constexpr (PHON(9)) final_phase(a, (const float*)(ws + WS_ST0), (const bf16_t*)(ws + WS_XB), g_wave);
        } else {
            const int l = (ph - 1) / 7, s = (ph - 1) % 7;
            unsigned char* wl = ws + WS_W + (size_t)l * W_LAYER;
            float* stA = (float*)(ws + (l == 0 ? WS_ST0 : WS_ST1));
            float* stB = (float*)(ws + (l == 0 ? WS_ST1 : WS_ST0));
            bf16_t* XP = (bf16_t*)(ws + (l == 0 ? WS_XB : WS_PROJ));
            bf16_t* XQ = (bf16_t*)(ws + (l == 0 ? WS_PROJ : WS_XB));
            pg8::StaticOrder S;
            if (s == 0) {  if constexpr (PHON(0)) {
                pg8::Gemm g{XP, (const bf16_t*)(wl + W_IN), MTOK, NZ, DM}; S.init(MTOK, NZ, G, cblk);
                fill_tab<0>(tabg, S, stA, nullptr, g_wave);
                EpiWin E{tabl, (bf16_t*)(ws + WS_Z), (float*)(ws + WS_VST)};
                for (int rep = 0; rep < DUPN(0); ++rep) pg8::gemm_phase<EpiWin>(lds, g, S, E, g_wave); }
            } else if (s == 1) {  if constexpr (PHON(1)) {
                for (int rep = 0; rep < DUPN(1); ++rep) { sgu_phase(a, l, lds_raw, g_wave); __syncthreads(); }
                for (int rep = 0; rep < DUPN(10); ++rep) { s5_phase(a, l, lds_raw, g_wave); __syncthreads(); } }
            } else if (s == 2) {  if constexpr (PHON(2)) {
                pg8::Gemm g{(const bf16_t*)(ws + WS_ZS), (const bf16_t*)(wl + W_GLU), MTOK, DS, DS}; S.init(MTOK, DS, G, cblk);
                EpiGlu E{(const bf16_t*)(ws + WS_ZS), a.in[16] + l * DS, (bf16_t*)(ws + WS_MIX), (float*)(ws + WS_YBST)};
                for (int rep = 0; rep < DUPN(2); ++rep) pg8::gemm_phase<EpiGlu>(lds, g, S, E, g_wave); }
            } else if (s == 3) {  if constexpr (PHON(3)) {
                pg8::Gemm g{(const bf16_t*)(ws + WS_MIX), (const bf16_t*)(wl + W_OUT), MTOK, DM, DM}; S.init(MTOK, DM, G, cblk);
                fill_tab<1>(tabg, S, (const float*)(ws + WS_YAST), (const float*)(ws + WS_YBST), g_wave);
                EpiWout E{tabl, XP, stB};
                pg8::gemm_phase<EpiWout>(lds, g, S, E, g_wave); }
            } else if (s == 4) {  if constexpr (PHON(4)) {
                { pg8::Gemm g{XP, (const bf16_t*)(wl + W_UP), MTOK, NUP, DM}; S.init(MTOK, NUP, G, cblk);
                  fill_tab<0>(tabg, S, stB, nullptr, g_wave);
                  EpiUp E{tabl, a.in[22] + (size_t)l * 3 * NUP, a.in[23] + (size_t)l * NUP, (bf16_t*)(ws + WS_HID), (float*)(ws + WS_HALO)};
                  for (int rep = 0; rep < DUPN(4); ++rep) pg8::gemm_phase<EpiUp>(lds, g, S, E, g_wave); }
                { pg8::Gemm g{(const bf16_t*)(ws + WS_PB) + (size_t)l * MTOK * DP, (const bf16_t*)(wl + W_PROJ), MTOK, DM, DP}; S.init(MTOK, DM, G, cblk);
                  EpiProj E{XQ};
                  for (int rep = 0; rep < DUPN(5); ++rep) pg8::gemm_phase<EpiProj>(lds, g, S, E, g_wave); } }
            } else if (s == 5) {  if constexpr (PHON(6)) {
                pg8::Gemm g{(const bf16_t*)(ws + WS_HID), (const bf16_t*)(wl + W_DOWN), MTOK, DM, FF}; S.init(MTOK, DM, G, cblk);
                fixup_phase(a, l, S, g_wave);
                EpiDown E{XP, stA};
                pg8::gemm_phase<EpiDown>(lds, g, S, E, g_wave); }
            } else {  if constexpr (PHON(7)) {
                pg8::Gemm g{XP, (const bf16_t*)(wl + W_GATE), MTOK, DM, DM}; S.init(MTOK, DM, G, cblk);
                fill_tab<0>(tabg, S, stA, nullptr, g_wave);
                EpiGate E{tabl, XP, XQ, stB};
                pg8::gemm_phase<EpiGate>(lds, g, S, E, g_wave); }
            }
        }
#ifndef EXTRA_SYNCS
#define EXTRA_SYNCS 0
#endif
        if (ph + 1 < ph_hi) {
            if (ph_hi > 1000) grid.sync();
            XcdBarrier xb; xb.bar = (unsigned*)(ws + WS_CTL); xb.x = xb_xcc_id(); xb.st = (volatile LAS unsigned*)(lds + LDS_MISC);
            xcd_barrier(xb, g_wave); for (int e = 0; e < EXTRA_SYNCS; ++e) xcd_barrier(xb, g_wave);
        }
    }
}

extern "C" void kernel_launch(void* const* d_in, const int* in_sizes, int n_in, void* d_out, int out_size, void* d_ws, size_t ws_size, hipStream_t stream) {
    static int grid = 0;
    if (grid == 0) {
        if (n_in != 29 || ws_size < WS_END) { fprintf(stderr, "kernel_launch: unexpected n_in %d / ws_size %zu\n", n_in, ws_size); grid = -1; return; }
        int dev = 0, cus = 0, per_cu = 0;
        hipGetDevice(&dev);
        hipDeviceGetAttribute(&cus, hipDeviceAttributeMultiprocessorCount, dev);
        if (hipFuncSetAttribute((const void*)fwd_kernel, hipFuncAttributeMaxDynamicSharedMemorySize, LDS_BYTES) != hipSuccess) { fprintf(stderr, "kernel_launch: hipFuncSetAttribute failed\n"); grid = -1; return; }
        hipOccupancyMaxActiveBlocksPerMultiprocessor(&per_cu, (const void*)fwd_kernel, 512, LDS_BYTES);
        (void)hipGetLastError();
        if (per_cu < 1) per_cu = 1;
        grid = cus * 1;
        if (grid <= 0) grid = 256;
    }
    if (grid < 0) return;
    if (hipMemsetAsync((char*)d_ws + WS_CTL, 0, CTL_BYTES, stream) != hipSuccess) { fprintf(stderr, "kernel_launch: memset of the barrier words failed\n"); return; }
    Args a{};
    for (int i = 0; i < 29; ++i) a.in[i] = (const float*)d_in[i];
    a.out = (float*)d_out; a.ws = (unsigned char*)d_ws;
#if MULTI_LAUNCH
    for (int ph = 0; ph < 16; ++ph) {
        a.ph_lo = ph; a.ph_hi = ph + 1;
        hipLaunchKernelGGL(fwd_kernel, dim3(grid), dim3(512), LDS_BYTES, stream, a);
    }
#else
    a.ph_lo = 0; a.ph_hi = 16;
    void* args[] = {&a};
    hipError_t e = hipLaunchCooperativeKernel((const void*)fwd_kernel, dim3(grid), dim3(512), args, LDS_BYTES, stream);
    if (e != hipSuccess) fprintf(stderr, "cooperative launch failed: %s (grid %d)\n", hipGetErrorString(e), grid);
#endif
}
```

```cpp
#include <hip/hip_runtime.h>
#include <hip/hip_cooperative_groups.h>
#include <cstdio>
#include <cstdint>
namespace cg = cooperative_groups;

#ifndef MULTI_LAUNCH
#define MULTI_LAUNCH 0
#endif
#ifndef PH_MASK
#define PH_MASK 0x3FF
#endif
#define PHON(k) (((PH_MASK) >> (k)) & 1)
#ifndef DUP_MASK
#define DUP_MASK 0
#endif
#define DUPN(k) ((((DUP_MASK) >> (k)) & 1) ? 2 : 1)

#define LAS __attribute__((address_space(3)))
typedef unsigned short bf16_t;
typedef short bf16x8 __attribute__((ext_vector_type(8)));
typedef float f32x4 __attribute__((ext_vector_type(4)));
typedef float f32x2 __attribute__((ext_vector_type(2)));
typedef unsigned u32x4 __attribute__((ext_vector_type(4)));
typedef unsigned u32x2 __attribute__((ext_vector_type(2)));

constexpr int MTOK = 32768, SEQ = 2048, DM = 2048, NZ = 3072, DS = 1024, FF = 5632, NUP = 11264, DP = 256;
constexpr float EPS = 1e-6f;
constexpr size_t MiB = 1u << 20;
constexpr size_t WS_ST0 = 0, WS_ST1 = 4 * MiB, WS_VST = 8 * MiB, WS_YAST = 12 * MiB, WS_YBST = 16 * MiB, WS_S5P = 18 * MiB, WS_SGUW = 20 * MiB, WS_HALO = 22 * MiB;
constexpr size_t WS_W = 66 * MiB;
constexpr size_t W_IN = 0, W_GLU = 12 * MiB, W_OUT = 14 * MiB, W_UP = 22 * MiB, W_DOWN = 66 * MiB, W_GATE = 88 * MiB, W_PROJ = 96 * MiB, W_LAYER = 97 * MiB;
constexpr size_t WS_PB = 260 * MiB;
constexpr size_t WS_XB = 292 * MiB;
constexpr size_t WS_BIG = 420 * MiB;
constexpr size_t WS_Z = WS_BIG, WS_ZS = WS_BIG + 192 * MiB, WS_MIX = WS_BIG + 256 * MiB, WS_HID = WS_BIG;
constexpr size_t WS_PROJ = 804 * MiB;
constexpr size_t WS_CTL = 932 * MiB, CTL_BYTES = 16384;
constexpr size_t WS_END = 933 * MiB;
constexpr size_t S5_BCAT = 0, S5_CMT = 256 * 1024, S5_AA = 512 * 1024, S5_LAYER = 1 * MiB;

constexpr int LDS_RING = 131072, LDS_TAB = 24576, LDS_MISC = LDS_RING + LDS_TAB, LDS_BYTES = LDS_MISC + 64;

typedef __bf16 bf16x2_t __attribute__((ext_vector_type(2)));
__device__ __forceinline__ unsigned cvt_pk_bf16(float lo, float hi) { const f32x2 v = {lo, hi}; const bf16x2_t b = __builtin_convertvector(v, bf16x2_t); return __builtin_bit_cast(unsigned, b); }
__device__ __forceinline__ float bf_lo(unsigned u) { return __uint_as_float(u << 16); }
__device__ __forceinline__ float bf_hi(unsigned u) { return __uint_as_float(u & 0xffff0000u); }
__device__ __forceinline__ float fast_sigmoid(float x) { return __builtin_amdgcn_rcpf(1.0f + __builtin_amdgcn_exp2f(-1.44269504089f * x)); }
__device__ __forceinline__ float gelu_tanh(float x) {
    const float t = x * x;
    const float e = __builtin_amdgcn_exp2f(x * __builtin_fmaf(t, -0.10294324f, -2.30220818f));
    return x * __builtin_amdgcn_rcpf(1.0f + e);
}
__device__ __forceinline__ unsigned lnd(unsigned x) { asm volatile("" : "+v"(x)); return x; }
__device__ __forceinline__ int lane_id() { int z; asm volatile("v_mbcnt_lo_u32_b32 %0, -1, 0\n\tv_mbcnt_hi_u32_b32 %0, -1, %0" : "=v"(z)); return z; }
#define THREAD_ID() (g_wave * 64 + lane_id())
__device__ __forceinline__ float wave_sum(float v) {
#pragma unroll
    for (int o = 1; o < 64; o <<= 1) v += __shfl_xor(v, o);
    return v;
}
__device__ __forceinline__ float red_fq(float s) { s += __shfl_xor(s, 16); s += __shfl_xor(s, 32); return s; }
__device__ __forceinline__ float slots_sum32(const float* slots, int row) {
    const f32x4* p = (const f32x4*)(slots + (size_t)row * 32); float s = 0.f;
#pragma unroll
    for (int j = 0; j < 8; ++j) { const f32x4 q = p[j]; s += (q.x + q.y) + (q.z + q.w); }
    return s;
}
__device__ __forceinline__ float slots_sum16(const float* slots, int row) {
    const f32x4* p = (const f32x4*)(slots + (size_t)row * 16); float s = 0.f;
#pragma unroll
    for (int j = 0; j < 4; ++j) { const f32x4 q = p[j]; s += (q.x + q.y) + (q.z + q.w); }
    return s;
}

namespace pg8 {
constexpr int BM = 256, BK = 64, HALF = 128, HTB = HALF * BK * 2, STAGE_BYTES = 8 * HTB, NXCD = 8, WGM = 8;
__host__ __device__ __forceinline__ int lds_byte(int r, int c) { const int st = (r >> 4) * 2 + (c >> 5), rr = r & 15, cc = c & 31, ob = rr * 64 + cc * 2; return st * 1024 + (ob ^ (((ob >> 9) & 1) << 5)); }
__host__ __device__ __forceinline__ void stage_rc(int b, int& R, int& C) { const int st = b / 1024, sb = b % 1024, swz = sb ^ (((sb >> 9) & 1) << 5); R = (st >> 1) * 16 + swz / 64; C = (st & 1) * 32 + (swz % 64) / 2; }
__host__ __device__ __forceinline__ int perm32(int rho) { const int n = rho >> 4, i = rho & 15; return 8 * (i >> 2) + 4 * n + (i & 3); }

struct Unit { int pm, pn; };
struct Gemm { const bf16_t* A; const bf16_t* Bt; int M, N, K; };

struct StaticOrder {
    int nM, nN, nwg, G, c;
    __device__ void init(int M, int N, int G_, int c_) { nM = M / BM; nN = N / BM; nwg = nM * nN; G = G_; c = c_; }
    __device__ bool next(int i, Unit& u) const {
        const long L = (long)i * G + c; if (L >= nwg) return false;
        int wgid = (int)L; { const int q = nwg / NXCD, r = nwg % NXCD, xcd = wgid % NXCD, off = wgid / NXCD; wgid = (xcd < r ? xcd * (q + 1) : r * (q + 1) + (xcd - r) * q) + off; }
        const int nig = WGM * nN, gid = wgid / nig, fm = gid * WGM, gsz = (nM - fm) < WGM ? (nM - fm) : WGM;
        u.pm = fm + ((wgid % nig) % gsz); u.pn = (wgid % nig) / gsz; return true;
    }
};

template <bool ROWPERM> __device__ __forceinline__ int epi_row(const Unit& u, int ai, int m, int wr, int fr) {
    return ROWPERM ? (u.pm * BM + 128 * wr + 8 * fr + 4 * ai + m) : (u.pm * BM + 128 * ai + 64 * wr + 16 * m + fr);
}

template <class Epi>
__device__ __forceinline__ void gemm_phase(LAS unsigned char* lds, const Gemm g, const StaticOrder& S, const Epi& E, const int g_wave) {
    constexpr bool ROWPERM = Epi::ROWPERM;
    int tid_ = THREAD_ID(); asm volatile("" : "+v"(tid_));
    const int tid = tid_, wid = __builtin_amdgcn_readfirstlane(tid >> 6), lane = tid & 63, wr = wid >> 2, wc = wid & 3, fr = lane & 15, fq = lane >> 4;
    const int K = g.K, nt = K / BK;
    unsigned voffA[2], voffB[2];
#pragma unroll
    for (int i = 0; i < 2; ++i) { int R, C; stage_rc(tid * 16 + i * 8192, R, C); const int Rb = (R & ~31) + perm32(R & 31);
        const int Ra = ROWPERM ? (128 * (R >> 6) + 8 * (R & 15) + ((R >> 4) & 3)) : R;
        voffA[i] = (unsigned)(Ra * K + C) * 2u; voffB[i] = (unsigned)(Rb * K + C) * 2u; }
    const size_t kstep = (size_t)(BK * 2);
    const size_t hstepB = (size_t)HALF * K * 2;
    const size_t hstepA = ROWPERM ? (size_t)4 * K * 2 : hstepB;
    const size_t tstep = 2 * hstepB;
    const unsigned ldsw = (unsigned)wid * 1024u;
    const int aoff = lds_byte(wr * 64 + fr, fq * 8), boff = lds_byte(wc * 32 + fr, fq * 8);
#define PG8_SA(b, h) (((b) * 2 + (h)) * HTB)
#define PG8_SB(b, h) ((4 + (b) * 2 + (h)) * HTB)
#define PG8_STAGE(bufoff, gbase, voff) do { _Pragma("unroll") for (int _i = 0; _i < 2; ++_i) \
        __builtin_amdgcn_global_load_lds((const unsigned*)((const char*)(gbase) + (voff)[_i]), (LAS unsigned*)(lds + (bufoff) + ldsw + _i * 8192), 16, 0, 0); } while (0)
#define PG8_LDA(dst, b, h) do { _Pragma("unroll") for (int m = 0; m < 4; ++m) _Pragma("unroll") for (int k = 0; k < 2; ++k) dst[m][k] = *(const LAS bf16x8*)(lds + PG8_SA(b, h) + aoff + m * 2048 + k * 1024); } while (0)
#define PG8_LDB(dst, b, h) do { _Pragma("unroll") for (int n = 0; n < 2; ++n) _Pragma("unroll") for (int k = 0; k < 2; ++k) dst[n][k] = *(const LAS bf16x8*)(lds + PG8_SB(b, h) + boff + n * 2048 + k * 1024); } while (0)
#define PG8_MMA(ai, bj, At, Bt) do { __builtin_amdgcn_s_setprio(1); _Pragma("unroll") for (int m = 0; m < 4; ++m) _Pragma("unroll") for (int n = 0; n < 2; ++n) _Pragma("unroll") for (int k = 0; k < 2; ++k) \
        acc[ai][bj][m][n] = __builtin_amdgcn_mfma_f32_16x16x32_bf16(Bt[n][k], At[m][k], acc[ai][bj][m][n], 0, 0, 0); __builtin_amdgcn_s_setprio(0); } while (0)
#define PG8_WAIT_V(n) asm volatile("s_waitcnt vmcnt(" #n ")" ::: "memory")
#define PG8_WAIT_L(n) asm volatile("s_waitcnt lgkmcnt(" #n ")" ::: "memory")
#define PG8_BAR __builtin_amdgcn_s_barrier()
#define PG8_SCHED __builtin_amdgcn_sched_barrier(0)
    Unit cur, nxt; int ui = 0;
    if (!S.next(0, cur)) return;
    f32x4 acc[2][2][4][2];
#pragma unroll
    for (int a = 0; a < 2; ++a)
#pragma unroll
        for (int b = 0; b < 2; ++b)
#pragma unroll
            for (int m = 0; m < 4; ++m)
#pragma unroll
                for (int n = 0; n < 2; ++n) acc[a][b][m][n] = (f32x4){0.f, 0.f, 0.f, 0.f};
    bf16x8 At[4][2], B0[2][2], B1[2][2];
    const char* cA = (const char*)g.A + (size_t)cur.pm * tstep; const char* cB = (const char*)g.Bt + (size_t)cur.pn * tstep;
    PG8_STAGE(PG8_SB(0, 0), cB, voffB); PG8_STAGE(PG8_SB(0, 1), cB + hstepB, voffB); PG8_STAGE(PG8_SA(0, 0), cA, voffA); PG8_STAGE(PG8_SA(0, 1), cA + hstepA, voffA);
    if (wr == 1) PG8_BAR;
    PG8_WAIT_V(2); PG8_BAR;
    PG8_STAGE(PG8_SB(1, 0), cB + kstep, voffB); PG8_STAGE(PG8_SA(1, 0), cA + kstep, voffA); PG8_STAGE(PG8_SB(1, 1), cB + hstepB + kstep, voffB);
    PG8_WAIT_V(6); PG8_BAR;
    for (;;) {
        const bool has_next = S.next(ui + 1, nxt);
        const char* nA = has_next ? (const char*)g.A + (size_t)nxt.pm * tstep : cA; const char* nB = has_next ? (const char*)g.Bt + (size_t)nxt.pn * tstep : cB;
#pragma nounroll
        for (int t = 0; t < nt; t += 2) {
            const bool last = (t == nt - 2);
            const char* a1 = cA + (size_t)(t + 1) * kstep;
            const char* a2 = last ? nA : cA + (size_t)(t + 2) * kstep; const char* b2 = last ? nB : cB + (size_t)(t + 2) * kstep;
            const char* a3 = a2 + kstep; const char* b3 = b2 + kstep;
            if constexpr (Epi::MIDK) { if (t == (nt >> 1)) E.mid(acc, cur, ui, wr, wc, fr, fq); }
            const bool relax = (t == 0) && (ui > 0);
            PG8_LDB(B0, 0, 0); PG8_LDB(B1, 0, 1); PG8_SCHED; PG8_LDA(At, 0, 0); if (!relax) PG8_STAGE(PG8_SA(1, 1), a1 + hstepA, voffA);
            if (relax) PG8_WAIT_V(22); else PG8_WAIT_V(8);
            PG8_WAIT_L(0); PG8_BAR; PG8_MMA(0, 0, At, B0); PG8_MMA(0, 1, At, B1); PG8_BAR; PG8_SCHED;
            PG8_LDA(At, 0, 1); PG8_STAGE(PG8_SB(0, 0), b2, voffB); PG8_STAGE(PG8_SB(0, 1), b2 + hstepB, voffB); PG8_STAGE(PG8_SA(0, 0), a2, voffA);
            if (relax) PG8_WAIT_V(22); else PG8_WAIT_V(8);
            PG8_WAIT_L(0); PG8_BAR; PG8_MMA(1, 0, At, B0); PG8_MMA(1, 1, At, B1); PG8_BAR; PG8_SCHED;
            PG8_LDB(B0, 1, 0); PG8_LDB(B1, 1, 1); PG8_SCHED; PG8_LDA(At, 1, 0); PG8_STAGE(PG8_SA(0, 1), a2 + hstepA, voffA);
            if (relax) PG8_WAIT_V(22); else PG8_WAIT_V(8);
            PG8_WAIT_L(0); PG8_BAR; PG8_MMA(0, 0, At, B0); PG8_MMA(0, 1, At, B1); PG8_BAR; PG8_SCHED;
            PG8_LDA(At, 1, 1); PG8_STAGE(PG8_SB(1, 0), b3, voffB); PG8_STAGE(PG8_SB(1, 1), b3 + hstepB, voffB); PG8_STAGE(PG8_SA(1, 0), a3, voffA);
            PG8_WAIT_V(8); PG8_WAIT_L(0); PG8_BAR; PG8_MMA(1, 0, At, B0); PG8_MMA(1, 1, At, B1); PG8_BAR; PG8_SCHED;
        }
        if (has_next) PG8_STAGE(PG8_SA(1, 1), nA + kstep + hstepA, voffA);
        if (wr == 0) PG8_BAR;
        E(acc, cur, ui, wr, wc, fr, fq);
        if (!has_next) break;
#pragma unroll
        for (int a = 0; a < 2; ++a)
#pragma unroll
            for (int b = 0; b < 2; ++b)
#pragma unroll
                for (int m = 0; m < 4; ++m)
#pragma unroll
                    for (int n = 0; n < 2; ++n) acc[a][b][m][n] = (f32x4){0.f, 0.f, 0.f, 0.f};
        cur = nxt; cA = nA; cB = nB; ++ui;
        if (wr == 1) PG8_BAR;
    }
    PG8_WAIT_V(0);
    PG8_BAR;
#undef PG8_SA
#undef PG8_SB
#undef PG8_STAGE
#undef PG8_LDA
#undef PG8_LDB
#undef PG8_MMA
#undef PG8_WAIT_V
#undef PG8_WAIT_L
#undef PG8_BAR
#undef PG8_SCHED
}
}
using pg8::Unit;
typedef f32x4 AccT[2][2][4][2];

__device__ __forceinline__ void unpack8(const u32x4 w, f32x4& v0, f32x4& v1) {
    v0.x = bf_lo(w.x); v0.y = bf_hi(w.x); v0.z = bf_lo(w.y); v0.w = bf_hi(w.y); v1.x = bf_lo(w.z); v1.y = bf_hi(w.z); v1.z = bf_lo(w.w); v1.w = bf_hi(w.w);
}
__device__ __forceinline__ void store_x8(bf16_t* xb, size_t off, const f32x4 v0, const f32x4 v1, float& ssq) {
    u32x4 w; w.x = cvt_pk_bf16(v0.x, v0.y); w.y = cvt_pk_bf16(v0.z, v0.w); w.z = cvt_pk_bf16(v1.x, v1.y); w.w = cvt_pk_bf16(v1.z, v1.w);
    *(u32x4*)(xb + off) = w;
    ssq += ((v0.x * v0.x + v0.y * v0.y) + (v0.z * v0.z + v0.w * v0.w)) + ((v1.x * v1.x + v1.y * v1.y) + (v1.z * v1.z + v1.w * v1.w));
}

struct EpiWin {
    static constexpr bool ROWPERM = false, MIDK = false;
    const LAS float* tab; bf16_t* Z; float* vst;
    __device__ __forceinline__ void operator()(AccT& acc, const Unit& u, int ui, int wr, int wc, int fr, int fq) const {
        const int col0 = u.pn * 256 + 32 * wc + 8 * fq; const int sect = u.pn >> 2;
#pragma unroll
        for (int ai = 0; ai < 2; ++ai)
#pragma unroll
            for (int m = 0; m < 4; ++m) {
                const int row = pg8::epi_row<false>(u, ai, m, wr, fr);
                const float rs = tab[ui * 256 + (row & 255)];
                float s1 = 0.f, s2 = 0.f;
#pragma unroll
                for (int bj = 0; bj < 2; ++bj) {
                    f32x4 v0 = acc[ai][bj][m][0] * rs, v1 = acc[ai][bj][m][1] * rs;
                    if (sect < 2) {
#pragma unroll
                        for (int j = 0; j < 4; ++j) { v0[j] = gelu_tanh(v0[j]); v1[j] = gelu_tanh(v1[j]); }
                    }
                    if (sect == 1) {
                        s1 += ((v0.x + v0.y) + (v0.z + v0.w)) + ((v1.x + v1.y) + (v1.z + v1.w));
                        s2 += ((v0.x * v0.x + v0.y * v0.y) + (v0.z * v0.z + v0.w * v0.w)) + ((v1.x * v1.x + v1.y * v1.y) + (v1.z * v1.z + v1.w * v1.w));
                    }
                    u32x4 w; w.x = cvt_pk_bf16(v0.x, v0.y); w.y = cvt_pk_bf16(v0.z, v0.w); w.z = cvt_pk_bf16(v1.x, v1.y); w.w = cvt_pk_bf16(v1.z, v1.w);
                    *(u32x4*)(Z + (size_t)row * NZ + col0 + 128 * bj) = w;
                }
                if (sect == 1) {
                    s1 = red_fq(s1); s2 = red_fq(s2);
                    if (fq == 0) *(f32x2*)(vst + ((size_t)row * 16 + (u.pn - 4) * 4 + wc) * 2) = (f32x2){s1, s2};
                }
            }
    }
};

struct EpiGlu {
    static constexpr bool ROWPERM = false, MIDK = false;
    const bf16_t* ZS; const float* bias; bf16_t* MIXB; float* ybst;
    __device__ __forceinline__ void operator()(AccT& acc, const Unit& u, int ui, int wr, int wc, int fr, int fq) const {
        const int col0 = u.pn * 256 + 32 * wc + 8 * fq;
#pragma unroll
        for (int ai = 0; ai < 2; ++ai)
#pragma unroll
            for (int m = 0; m < 4; ++m) {
                const int row = pg8::epi_row<false>(u, ai, m, wr, fr);
                float ssq = 0.f;
#pragma unroll
                for (int bj = 0; bj < 2; ++bj) {
                    const int col = col0 + 128 * bj;
                    const u32x4 zz = *(const u32x4*)(ZS + (size_t)row * DS + col);
                    const f32x4 b0 = *(const f32x4*)(bias + col), b1 = *(const f32x4*)(bias + col + 4);
                    const f32x4 a0 = acc[ai][bj][m][0] + b0, a1 = acc[ai][bj][m][1] + b1;
                    float y[8];
                    y[0] = bf_lo(zz.x) * fast_sigmoid(a0.x); y[1] = bf_hi(zz.x) * fast_sigmoid(a0.y); y[2] = bf_lo(zz.y) * fast_sigmoid(a0.z); y[3] = bf_hi(zz.y) * fast_sigmoid(a0.w);
                    y[4] = bf_lo(zz.z) * fast_sigmoid(a1.x); y[5] = bf_hi(zz.z) * fast_sigmoid(a1.y); y[6] = bf_lo(zz.w) * fast_sigmoid(a1.z); y[7] = bf_hi(zz.w) * fast_sigmoid(a1.w);
#pragma unroll
                    for (int j = 0; j < 8; ++j) ssq += y[j] * y[j];
                    u32x4 w; w.x = cvt_pk_bf16(y[0], y[1]); w.y = cvt_pk_bf16(y[2], y[3]); w.z = cvt_pk_bf16(y[4], y[5]); w.w = cvt_pk_bf16(y[6], y[7]);
                    *(u32x4*)(MIXB + (size_t)row * DM + DS + col) = w;
                }
                ssq = red_fq(ssq);
                if (fq == 0) ybst[(size_t)row * 16 + u.pn * 4 + wc] = ssq;
            }
    }
};

struct EpiWout {
    static constexpr bool ROWPERM = false, MIDK = true;
    const LAS float* tab; bf16_t* X; float* stout;
    __device__ __forceinline__ void mid(AccT& acc, const Unit& u, int ui, int wr, int wc, int fr, int fq) const {
#pragma unroll
        for (int ai = 0; ai < 2; ++ai)
#pragma unroll
            for (int m = 0; m < 4; ++m) {
                const int row = pg8::epi_row<false>(u, ai, m, wr, fr);
                const float ratio = tab[ui * 256 + (row & 255)];
#pragma unroll
                for (int bj = 0; bj < 2; ++bj) { acc[ai][bj][m][0] *= ratio; acc[ai][bj][m][1] *= ratio; }
            }
    }
    __device__ __forceinline__ void operator()(AccT& acc, const Unit& u, int ui, int wr, int wc, int fr, int fq) const {
        const int col0 = u.pn * 256 + 32 * wc + 8 * fq;
#pragma unroll
        for (int ai = 0; ai < 2; ++ai) {
            u32x4 xr[4][2];
#pragma unroll
            for (int m = 0; m < 4; ++m)
#pragma unroll
                for (int bj = 0; bj < 2; ++bj) xr[m][bj] = *(const u32x4*)(X + (size_t)pg8::epi_row<false>(u, ai, m, wr, fr) * DM + col0 + 128 * bj);
#pragma unroll
            for (int m = 0; m < 4; ++m) {
                const int row = pg8::epi_row<false>(u, ai, m, wr, fr);
                const float rb = tab[1024 + ui * 256 + (row & 255)];
                float ssq = 0.f;
#pragma unroll
                for (int bj = 0; bj < 2; ++bj) {
                    f32x4 x0, x1; unpack8(xr[m][bj], x0, x1);
                    store_x8(X, (size_t)row * DM + col0 + 128 * bj, x0 + acc[ai][bj][m][0] * rb, x1 + acc[ai][bj][m][1] * rb, ssq);
                }
                ssq = red_fq(ssq);
                if (fq == 0) stout[(size_t)row * 32 + u.pn * 4 + wc] = ssq;
            }
        }
    }
};

struct EpiDown {
    static constexpr bool ROWPERM = false, MIDK = false;
    bf16_t* X; float* stout;
    __device__ __forceinline__ void operator()(AccT& acc, const Unit& u, int ui, int wr, int wc, int fr, int fq) const {
        const int col0 = u.pn * 256 + 32 * wc + 8 * fq;
#pragma unroll
        for (int ai = 0; ai < 2; ++ai) {
            u32x4 xr[4][2];
#pragma unroll
            for (int m = 0; m < 4; ++m)
#pragma unroll
                for (int bj = 0; bj < 2; ++bj) xr[m][bj] = *(const u32x4*)(X + (size_t)pg8::epi_row<false>(u, ai, m, wr, fr) * DM + col0 + 128 * bj);
#pragma unroll
            for (int m = 0; m < 4; ++m) {
                const int row = pg8::epi_row<false>(u, ai, m, wr, fr);
                float ssq = 0.f;
#pragma unroll
                for (int bj = 0; bj < 2; ++bj) {
                    f32x4 x0, x1; unpack8(xr[m][bj], x0, x1);
                    store_x8(X, (size_t)row * DM + col0 + 128 * bj, x0 + acc[ai][bj][m][0], x1 + acc[ai][bj][m][1], ssq);
                }
                ssq = red_fq(ssq);
                if (fq == 0) stout[(size_t)row * 32 + u.pn * 4 + wc] = ssq;
            }
        }
    }
};

struct EpiProj {
    static constexpr bool ROWPERM = false, MIDK = false;
    bf16_t* P;
    __device__ __forceinline__ void operator()(AccT& acc, const Unit& u, int ui, int wr, int wc, int fr, int fq) const {
        const int col0 = u.pn * 256 + 32 * wc + 8 * fq;
#pragma unroll
        for (int ai = 0; ai < 2; ++ai)
#pragma unroll
            for (int m = 0; m < 4; ++m) {
                const int row = pg8::epi_row<false>(u, ai, m, wr, fr);
#pragma unroll
                for (int bj = 0; bj < 2; ++bj) {
                    const f32x4 v0 = acc[ai][bj][m][0], v1 = acc[ai][bj][m][1];
                    u32x4 w; w.x = cvt_pk_bf16(v0.x, v0.y); w.y = cvt_pk_bf16(v0.z, v0.w); w.z = cvt_pk_bf16(v1.x, v1.y); w.w = cvt_pk_bf16(v1.z, v1.w);
                    *(u32x4*)(P + (size_t)row * DM + col0 + 128 * bj) = w;
                }
            }
    }
};

struct EpiGate {
    static constexpr bool ROWPERM = false, MIDK = false;
    const LAS float* tab; const bf16_t* XP; bf16_t* XQ; float* stout;
    __device__ __forceinline__ void operator()(AccT& acc, const Unit& u, int ui, int wr, int wc, int fr, int fq) const {
        const int col0 = u.pn * 256 + 32 * wc + 8 * fq;
#pragma unroll
        for (int ai = 0; ai < 2; ++ai) {
            u32x4 xr[4][2], pr[4][2];
#pragma unroll
            for (int m = 0; m < 4; ++m)
#pragma unroll
                for (int bj = 0; bj < 2; ++bj) { const size_t off = (size_t)pg8::epi_row<false>(u, ai, m, wr, fr) * DM + col0 + 128 * bj;
                    xr[m][bj] = *(const u32x4*)(XP + off); pr[m][bj] = *(const u32x4*)(XQ + off); }
#pragma unroll
            for (int m = 0; m < 4; ++m) {
                const int row = pg8::epi_row<false>(u, ai, m, wr, fr);
                const float rs = tab[ui * 256 + (row & 255)];
                float ssq = 0.f;
#pragma unroll
                for (int bj = 0; bj < 2; ++bj) {
                    f32x4 x0, x1, p0, p1; unpack8(xr[m][bj], x0, x1); unpack8(pr[m][bj], p0, p1);
                    const float rsn = -1.44269504089f * rs;
                    const f32x4 a0 = acc[ai][bj][m][0] * rsn, a1 = acc[ai][bj][m][1] * rsn;
                    f32x4 n0, n1;
#pragma unroll
                    for (int e = 0; e < 4; ++e) { n0[e] = x0[e] + __builtin_amdgcn_rcpf(1.0f + __builtin_amdgcn_exp2f(a0[e])) * p0[e]; n1[e] = x1[e] + __builtin_amdgcn_rcpf(1.0f + __builtin_amdgcn_exp2f(a1[e])) * p1[e]; }
                    store_x8(XQ, (size_t)row * DM + col0 + 128 * bj, n0, n1, ssq);
                }
                ssq = red_fq(ssq);
                if (fq == 0) stout[(size_t)row * 32 + u.pn * 4 + wc] = ssq;
            }
        }
    }
};

struct EpiUp {
    static constexpr bool ROWPERM = true, MIDK = false;
    const LAS float* tab; const float* cw; const float* cb; bf16_t* HID; float* halo;
    __device__ __forceinline__ void conv_inplace(AccT& acc, int bj, int n, const float (&rs)[8], const float* cwp, const float* cbp, float* hp, int fr) const {
        const f32x4 w0 = *(const f32x4*)(cwp), w1 = *(const f32x4*)(cwp + NUP), w2 = *(const f32x4*)(cwp + 2 * NUP), bb = *(const f32x4*)(cbp);
#pragma unroll
        for (int j = 0; j < 8; ++j) acc[j >> 2][bj][j & 3][n] *= rs[j];
        f32x4 p1, p2;
#pragma unroll
        for (int e = 0; e < 4; ++e) { p1[e] = __shfl_up(acc[1][bj][3][n][e], 1, 16); p2[e] = __shfl_up(acc[1][bj][2][n][e], 1, 16); }
        if (fr == 0) { *(f32x4*)(hp) = acc[0][bj][0][n]; *(f32x4*)(hp + NUP) = acc[0][bj][1][n]; }
        if (fr == 15) { *(f32x4*)(hp + 2 * NUP) = acc[1][bj][2][n]; *(f32x4*)(hp + 3 * NUP) = acc[1][bj][3][n]; }
#pragma unroll
        for (int j = 7; j >= 0; --j) {
            const f32x4 m1 = (j >= 1) ? acc[(j - 1 >= 0 ? j - 1 : 0) >> 2][bj][(j - 1 >= 0 ? j - 1 : 0) & 3][n] : p1;
            const f32x4 m2 = (j >= 2) ? acc[(j - 2 >= 0 ? j - 2 : 0) >> 2][bj][(j - 2 >= 0 ? j - 2 : 0) & 3][n] : (j == 1 ? p1 : p2);
            acc[j >> 2][bj][j & 3][n] = w2 * acc[j >> 2][bj][j & 3][n] + (w1 * m1 + (w0 * m2 + bb));
        }
    }
    __device__ __forceinline__ void operator()(AccT& acc, const Unit& u, int ui, int wr, int wc, int fr, int fq) const {
        const int T0 = u.pm * 256 + 128 * wr + 8 * fr;
        const int G = u.pm * 2 + wr;
        const int tc0 = 32 * wc + 8 * fq;
        const int h0 = u.pn * 128 + tc0;
        float rs[8];
        { const LAS f32x4* tp = (const LAS f32x4*)(tab + ui * 256 + 128 * wr + 8 * fr); const f32x4 r0 = tp[0], r1 = tp[1];
          rs[0] = r0.x; rs[1] = r0.y; rs[2] = r0.z; rs[3] = r0.w; rs[4] = r1.x; rs[5] = r1.y; rs[6] = r1.z; rs[7] = r1.w; }
#pragma unroll
        for (int n = 0; n < 2; ++n) {
            const int hh = h0 + 4 * n;
            float* hp = halo + (size_t)G * 4 * NUP + (size_t)u.pn * 256 + tc0 + 4 * n;
            conv_inplace(acc, 0, n, rs, cw + hh, cb + hh, hp, fr);
            conv_inplace(acc, 1, n, rs, cw + FF + hh, cb + FF + hh, hp + 128, fr);
#pragma unroll
            for (int j = 0; j < 8; ++j) {
                const f32x4 cg_ = acc[j >> 2][0][j & 3][n], cu_ = acc[j >> 2][1][j & 3][n];
                f32x4 hv;
#pragma unroll
                for (int e = 0; e < 4; ++e) hv[e] = cg_[e] * fast_sigmoid(cg_[e]) * cu_[e];
                u32x2 w; w.x = cvt_pk_bf16(hv.x, hv.y); w.y = cvt_pk_bf16(hv.z, hv.w);
                *(u32x2*)(HID + (size_t)(T0 + j) * FF + hh) = w;
            }
        }
    }
};

struct Args { const float* in[29]; float* out; unsigned char* ws; int ph_lo, ph_hi; };

__device__ __forceinline__ void transpose_item(const float* W, int K, int N, const float* gk0, bf16_t* WT, int n0, int k0, int orow0, int lane) {
    const int kq = lane >> 4, nq = lane & 15;
    const float* src = W + (size_t)(k0 + 16 * kq) * N + n0 + 4 * nq;
    f32x4 v[16];
#pragma unroll
    for (int i = 0; i < 16; ++i) v[i] = *(const f32x4*)(src + (size_t)i * N);
    if (gk0) {
        const f32x4* gp = (const f32x4*)(gk0 + 16 * kq);
        const f32x4 g0 = gp[0], g1 = gp[1], g2 = gp[2], g3 = gp[3];
        v[0] *= g0.x; v[1] *= g0.y; v[2] *= g0.z; v[3] *= g0.w; v[4] *= g1.x; v[5] *= g1.y; v[6] *= g1.z; v[7] *= g1.w;
        v[8] *= g2.x; v[9] *= g2.y; v[10] *= g2.z; v[11] *= g2.w; v[12] *= g3.x; v[13] *= g3.y; v[14] *= g3.z; v[15] *= g3.w;
    }
#pragma unroll
    for (int e = 0; e < 4; ++e) {
        u32x4 o0, o1;
        o0.x = cvt_pk_bf16(v[0][e], v[1][e]); o0.y = cvt_pk_bf16(v[2][e], v[3][e]); o0.z = cvt_pk_bf16(v[4][e], v[5][e]); o0.w = cvt_pk_bf16(v[6][e], v[7][e]);
        o1.x = cvt_pk_bf16(v[8][e], v[9][e]); o1.y = cvt_pk_bf16(v[10][e], v[11][e]); o1.z = cvt_pk_bf16(v[12][e], v[13][e]); o1.w = cvt_pk_bf16(v[14][e], v[15][e]);
        bf16_t* dst = WT + (size_t)(orow0 + 4 * nq + e) * K + k0 + 16 * kq;
        *(u32x4*)dst = o0; *(u32x4*)(dst + 8) = o1;
    }
}

__device__ __forceinline__ double dsin_red(double r) {
    const double r2 = r * r; double term = r, s = r;
#pragma unroll 1
    for (int k = 1; k <= 14; ++k) { term *= -r2 / (double)((2 * k) * (2 * k + 1)); s += term; }
    return s;
}
__device__ __forceinline__ double dcos_red(double r) {
    const double r2 = r * r; double term = 1.0, s = 1.0;
#pragma unroll 1
    for (int k = 1; k <= 14; ++k) { term *= -r2 / (double)((2 * k - 1) * (2 * k)); s += term; }
    return s;
}
__device__ __forceinline__ double dexp_small(double x) {
    double term = 1.0, s = 1.0;
#pragma unroll 1
    for (int k = 1; k <= 16; ++k) { term *= x / (double)k; s += term; }
    return s;
}

__device__ __forceinline__ void prologue(const Args& a, unsigned char* lds_raw, const int g_wave) {
    unsigned char* ws = a.ws;
    int tid_ = THREAD_ID(); asm volatile("" : "+v"(tid_));
    const int tid = tid_, lane = tid & 63, wave = tid >> 6;
    const int G = gridDim.x, gw = blockIdx.x * 8 + wave, NGW = G * 8;
    const int gt = blockIdx.x * 512 + tid, NGT = G * 512;
    constexpr int I_IN = (DM / 64) * (NZ / 64), I_GLU = (DS / 64) * (DS / 64), I_OUT = (DM / 64) * (DM / 64), I_UP = (DM / 64) * (NUP / 64), I_DOWN = (FF / 64) * (DM / 64), I_GATE = (DM / 64) * (DM / 64), I_PROJ = (DP / 64) * (DM / 64);
    constexpr int I_LAYER = I_IN + I_GLU + I_OUT + I_UP + I_DOWN + I_GATE + I_PROJ;
    for (int it = gw; it < 2 * I_LAYER; it += NGW) {
        const int l = it / I_LAYER; int r = it % I_LAYER;
        unsigned char* wl = ws + WS_W + (size_t)l * W_LAYER;
        if (r < I_IN) { const int nblk = NZ / 64, kb = r / nblk, nb = r % nblk;
            transpose_item(a.in[3] + (size_t)l * DM * NZ, DM, NZ, a.in[2] + l * DM + kb * 64, (bf16_t*)(wl + W_IN), nb * 64, kb * 64, nb * 64, lane); continue; } r -= I_IN;
        if (r < I_GLU) { const int nblk = DS / 64, kb = r / nblk, nb = r % nblk;
            transpose_item(a.in[15] + (size_t)l * DS * DS, DS, DS, nullptr, (bf16_t*)(wl + W_GLU), nb * 64, kb * 64, nb * 64, lane); continue; } r -= I_GLU;
        if (r < I_OUT) { const int nblk = DM / 64, kb = r / nblk, nb = r % nblk; const int k0 = kb * 64;
            const float* gk = (k0 < DS) ? (a.in[17] + l * DS + k0) : (a.in[18] + l * DS + (k0 - DS));
            transpose_item(a.in[19] + (size_t)l * DM * DM, DM, DM, gk, (bf16_t*)(wl + W_OUT), nb * 64, k0, nb * 64, lane); continue; } r -= I_OUT;
        if (r < I_UP) { const int nblk = NUP / 64, kb = r / nblk, nb = r % nblk; const int n0 = nb * 64;
            const int bj = (n0 >= FF) ? 1 : 0, h = n0 - bj * FF, o0 = (h >> 7) * 256 + bj * 128 + (h & 127);
            transpose_item(a.in[21] + (size_t)l * DM * NUP, DM, NUP, a.in[20] + l * DM + kb * 64, (bf16_t*)(wl + W_UP), n0, kb * 64, o0, lane); continue; } r -= I_UP;
        if (r < I_DOWN) { const int nblk = DM / 64, kb = r / nblk, nb = r % nblk;
            transpose_item(a.in[24] + (size_t)l * FF * DM, FF, DM, nullptr, (bf16_t*)(wl + W_DOWN), nb * 64, kb * 64, nb * 64, lane); continue; } r -= I_DOWN;
        if (r < I_GATE) { const int nblk = DM / 64, kb = r / nblk, nb = r % nblk;
            transpose_item(a.in[26] + (size_t)l * DM * DM, DM, DM, a.in[25] + l * DM + kb * 64, (bf16_t*)(wl + W_GATE), nb * 64, kb * 64, nb * 64, lane); continue; } r -= I_GATE;
        { const int nblk = DM / 64, kb = r / nblk, nb = r % nblk;
            transpose_item(a.in[27] + (size_t)l * DP * DM, DP, DM, nullptr, (bf16_t*)(wl + W_PROJ), nb * 64, kb * 64, nb * 64, lane); }
    }
    {
        const float* x = a.in[0]; bf16_t* XB = (bf16_t*)(ws + WS_XB); float* st0 = (float*)(ws + WS_ST0);
        for (int row0 = gw; row0 < MTOK; row0 += 2 * NGW) {
            f32x4 v[2][8];
#pragma unroll
            for (int q = 0; q < 2; ++q) { const int row = (row0 + q * NGW < MTOK) ? row0 + q * NGW : row0; const f32x4* xr = (const f32x4*)(x + (size_t)row * DM) + lane;
#pragma unroll
                for (int j = 0; j < 8; ++j) v[q][j] = xr[64 * j]; }
#pragma unroll
            for (int q = 0; q < 2; ++q) { const int row = row0 + q * NGW; if (row >= MTOK) continue;
                float s = 0.f;
#pragma unroll
                for (int j = 0; j < 8; ++j) s += (v[q][j].x * v[q][j].x + v[q][j].y * v[q][j].y) + (v[q][j].z * v[q][j].z + v[q][j].w * v[q][j].w);
                s = wave_sum(s);
                u32x2* o = (u32x2*)(XB + (size_t)row * DM) + lane;
#pragma unroll
                for (int j = 0; j < 8; ++j) { u32x2 w; w.x = cvt_pk_bf16(v[q][j].x, v[q][j].y); w.y = cvt_pk_bf16(v[q][j].z, v[q][j].w); o[64 * j] = w; }
                if (lane < 32) st0[(size_t)row * 32 + lane] = (lane == 0) ? s : 0.f; }
        }
    }
    {
        const f32x4* p4 = (const f32x4*)a.in[1]; u32x2* o = (u32x2*)(ws + WS_PB);
        const int n4 = 2 * MTOK * DP / 4;
        for (int i0 = gt; i0 < n4; i0 += 8 * NGT) {
            f32x4 v[8];
#pragma unroll
            for (int j = 0; j < 8; ++j) { const int i = i0 + j * NGT; v[j] = (i < n4) ? p4[i] : (f32x4){0.f, 0.f, 0.f, 0.f}; }
#pragma unroll
            for (int j = 0; j < 8; ++j) { const int i = i0 + j * NGT; if (i < n4) { u32x2 w; w.x = cvt_pk_bf16(v[j].x, v[j].y); w.y = cvt_pk_bf16(v[j].z, v[j].w); o[i] = w; } }
        }
    }
    {
        const float* w = a.in[5]; bf16_t* o = (bf16_t*)(ws + WS_SGUW);
        for (int i = gt; i < 2 * 8 * 128 * 128; i += NGT) { const int s = i & 127, t = (i >> 7) & 127; const float v = (s <= t) ? w[i] : 0.f; o[i] = (bf16_t)(cvt_pk_bf16(v, 0.f) & 0xffffu); }
    }
    for (int i = gt; i < 2 * 64 * 64; i += NGT) {
        const int l = i >> 12, g = (i >> 6) & 63, n = i & 63;
        unsigned char* sp = ws + WS_S5P + (size_t)l * S5_LAYER;
        const double lr = (double)a.in[7][i], li = (double)a.in[8][i];
        const double dt = (double)expf(a.in[9][l * 64 + g]);
        const double mag = dexp_small(lr * dt);
        const double th = li * dt; const double kq = rint(th * 0.15915494309189533577); const double rr = th - kq * 6.283185307179586476925;
        const double abr = mag * dcos_red(rr), abi = mag * dsin_red(rr);
        const double den = lr * lr + li * li, nr = abr - 1.0;
        const double qr = (nr * lr + abi * li) / den, qi = (abi * lr - nr * li) / den;
        *(f32x2*)((float*)(sp + S5_AA) + ((size_t)g * 64 + n) * 2) = (f32x2){(float)abr, (float)abi};
        bf16_t* bc = (bf16_t*)(sp + S5_BCAT) + ((size_t)g * 128 + 2 * n) * 16;
        const float* bre = a.in[10] + (size_t)i * 16; const float* bim = a.in[11] + (size_t)i * 16;
#pragma unroll
        for (int c = 0; c < 16; c += 2) {
            const double r0 = bre[c], i0 = bim[c], r1 = bre[c + 1], i1 = bim[c + 1];
            *(unsigned*)(bc + c) = cvt_pk_bf16((float)(qr * r0 - qi * i0), (float)(qr * r1 - qi * i1));
            *(unsigned*)(bc + 16 + c) = cvt_pk_bf16((float)(qr * i0 + qi * r0), (float)(qr * i1 + qi * r1));
        }
        bf16_t* cm = (bf16_t*)(sp + S5_CMT) + (size_t)g * 16 * 128 + 2 * n;
        const float* cre = a.in[12] + ((size_t)(l * 64 + g) * 16) * 64 + n; const float* cim = a.in[13] + ((size_t)(l * 64 + g) * 16) * 64 + n;
#pragma unroll
        for (int c = 0; c < 16; ++c) *(unsigned*)(cm + c * 128) = cvt_pk_bf16(cre[c * 64], -cim[c * 64]);
    }
}

__device__ __forceinline__ void sgu_phase(const Args& a, int l, unsigned char* lds_raw, const int g_wave) {
    unsigned char* ws = a.ws;
    int tid_ = THREAD_ID(); asm volatile("" : "+v"(tid_));
    const int tid = tid_, lane = tid & 63, wid = tid >> 6, wr = wid >> 2, wc = wid & 3, fr = lane & 15, fq = lane >> 4;
    const bf16_t* Z = (const bf16_t*)(ws + WS_Z); bf16_t* MIX = (bf16_t*)(ws + WS_MIX);
    const float* vst = (const float*)(ws + WS_VST); float* yast = (float*)(ws + WS_YAST);
    const float* gsgu = a.in[4] + l * DS; const float* sb = a.in[6] + l * 8 * 128;
    const bf16_t* Wm = (const bf16_t*)(ws + WS_SGUW) + (size_t)l * 8 * 128 * 128;
    float* stat = (float*)lds_raw;
    bf16_t* vT0 = (bf16_t*)(lds_raw + 1024);
#define SGU_LOAD_V(hv, VV) do { const bf16_t* Zh = Z + 128 * (hv); \
        _Pragma("unroll") for (int i = 0; i < 4; ++i) VV[i] = *(const u32x4*)(Zh + DS + lnd(zvo[i])); } while (0)
#define SGU_LOAD_U(hv, UU, BI) do { const int h_ = (hv); const bf16_t* Zh = Z + 128 * h_; const float* sbh = sb + 128 * h_; \
        _Pragma("unroll") for (int m = 0; m < 4; ++m) { BI[m] = sbh[64 * wr + 16 * m + fr]; \
            _Pragma("unroll") for (int n = 0; n < 2; ++n) UU[m][n] = *(const u32x2*)(Zh + lnd(zuo[m]) + 16 * n); } } while (0)
#define SGU_LOAD_AF(hv) do { const bf16_t* Wh = Wm + (size_t)(hv) * 128 * 128; \
        _Pragma("unroll") for (int k = 0; k < 4; ++k) _Pragma("unroll") for (int m = 0; m < 4; ++m) af[k][m] = *(const bf16x8*)(Wh + lnd(wao) + 16 * 128 * m + 32 * k); } while (0)
#define SGU_STAGE(hv, VV, bufv) do { const int h_ = (hv); bf16_t* vT = vT0 + (bufv) * (128 * 136); const float* gh = gsgu + 128 * h_; \
        _Pragma("unroll") for (int i = 0; i < 4; ++i) { const int idx = tid + 512 * i, s = idx >> 4, c8 = idx & 15; \
            const float mean = stat[2 * s], rstd = stat[2 * s + 1]; \
            const f32x4 g0 = *(const f32x4*)(gh + 8 * c8), g1 = *(const f32x4*)(gh + 8 * c8 + 4); \
            float e[8]; \
            e[0] = (bf_lo(VV[i].x) - mean) * rstd * g0.x; e[1] = (bf_hi(VV[i].x) - mean) * rstd * g0.y; e[2] = (bf_lo(VV[i].y) - mean) * rstd * g0.z; e[3] = (bf_hi(VV[i].y) - mean) * rstd * g0.w; \
            e[4] = (bf_lo(VV[i].z) - mean) * rstd * g1.x; e[5] = (bf_hi(VV[i].z) - mean) * rstd * g1.y; e[6] = (bf_lo(VV[i].w) - mean) * rstd * g1.z; e[7] = (bf_hi(VV[i].w) - mean) * rstd * g1.w; \
            _Pragma("unroll") for (int j = 0; j < 8; ++j) vT[(8 * c8 + j) * 136 + (s ^ (c8 << 3))] = (bf16_t)(cvt_pk_bf16(e[j], 0.f) & 0xffffu); } } while (0)
#define SGU_MMA(bufv) do { const bf16_t* vT = vT0 + (bufv) * (128 * 136); \
        _Pragma("unroll") for (int m = 0; m < 4; ++m) { acc[m][0] = (f32x4){0.f, 0.f, 0.f, 0.f}; acc[m][1] = (f32x4){0.f, 0.f, 0.f, 0.f}; } \
        _Pragma("unroll") for (int k = 0; k < 4; ++k) { bf16x8 bf[2]; \
            _Pragma("unroll") for (int n = 0; n < 2; ++n) bf[n] = *(const bf16x8*)(vT + (32 * wc + 16 * n + fr) * 136 + 8 * ((4 * k + fq) ^ (((32 * wc + 16 * n + fr) >> 3) & 15))); \
            _Pragma("unroll") for (int m = 0; m < 4; ++m) _Pragma("unroll") for (int n = 0; n < 2; ++n) acc[m][n] = __builtin_amdgcn_mfma_f32_16x16x32_bf16(bf[n], af[k][m], acc[m][n], 0, 0, 0); } } while (0)
#define SGU_EPI(hv, UU, BI) do { const int h_ = (hv); bf16_t* Mh = MIX + 128 * h_; float* yh = yast + 4 * h_; \
        _Pragma("unroll") for (int m = 0; m < 4; ++m) { float ssq = 0.f; \
            _Pragma("unroll") for (int n = 0; n < 2; ++n) { const f32x4 q = acc[m][n] + BI[m]; \
                const float y0 = bf_lo(UU[m][n].x) * q.x, y1 = bf_hi(UU[m][n].x) * q.y, y2 = bf_lo(UU[m][n].y) * q.z, y3 = bf_hi(UU[m][n].y) * q.w; \
                ssq += (y0 * y0 + y1 * y1) + (y2 * y2 + y3 * y3); \
                u32x2 w; w.x = cvt_pk_bf16(y0, y1); w.y = cvt_pk_bf16(y2, y3); *(u32x2*)(Mh + lnd(mxo) + (unsigned)(16 * m) * DM + 16 * n) = w; } \
            ssq = red_fq(ssq); if (fq == 0) yh[lnd(yso) + 16 * 32 * m] = ssq; } } while (0)
    for (int chunk = blockIdx.x; chunk < MTOK / 128; chunk += gridDim.x) {
        const int T0 = chunk * 128;
        unsigned zvo[4], zuo[4];
#pragma unroll
        for (int i = 0; i < 4; ++i) { const int idx = tid + 512 * i, s_ = idx >> 4, c8 = idx & 15; zvo[i] = (unsigned)(T0 + s_) * NZ + 8 * c8; }
#pragma unroll
        for (int m = 0; m < 4; ++m) zuo[m] = (unsigned)(T0 + 64 * wr + 16 * m + fr) * NZ + 32 * wc + 4 * fq;
        const unsigned wao = (unsigned)(64 * wr + fr) * 128 + 8 * fq;
        const unsigned mxo = (unsigned)(T0 + 64 * wr + fr) * DM + 32 * wc + 4 * fq;
        const unsigned yso = (unsigned)(T0 + 64 * wr + fr) * 32 + wc;
        u32x4 vvA[4], vvB[4]; u32x2 uu[4][2]; float bi[4]; bf16x8 af[4][4]; f32x4 acc[4][2];
        SGU_LOAD_V(0, vvA); SGU_LOAD_AF(0); SGU_LOAD_U(0, uu, bi);
        __syncthreads();
        if (tid < 128) {
            const f32x4* p = (const f32x4*)(vst + (size_t)(T0 + tid) * 32);
            float s1 = 0.f, s2 = 0.f;
#pragma unroll
            for (int j = 0; j < 8; ++j) { const f32x4 q = p[j]; s1 += q.x + q.z; s2 += q.y + q.w; }
            const float mean = s1 * (1.0f / DS); const float var = s2 * (1.0f / DS) - mean * mean;
            stat[2 * tid] = mean; stat[2 * tid + 1] = __builtin_amdgcn_rsqf(fmaxf(var, 0.f) + EPS);
        }
        __syncthreads();
#pragma nounroll
        for (int h = 0; h < 8; h += 2) {
            const int h2 = (h + 2 < 8) ? h + 2 : 7;
            SGU_LOAD_V(h + 1, vvB);
            SGU_STAGE(h, vvA, 0); __syncthreads(); SGU_MMA(0); SGU_LOAD_AF(h + 1); SGU_EPI(h, uu, bi); SGU_LOAD_U(h + 1, uu, bi);
            SGU_LOAD_V(h2, vvA);
            SGU_STAGE(h + 1, vvB, 1); __syncthreads(); SGU_MMA(1); SGU_LOAD_AF(h2); SGU_EPI(h + 1, uu, bi); SGU_LOAD_U(h2, uu, bi);
        }
    }
#undef SGU_LOAD_V
#undef SGU_LOAD_U
#undef SGU_LOAD_AF
#undef SGU_STAGE
#undef SGU_MMA
#undef SGU_EPI
}

__device__ __forceinline__ void s5_phase(const Args& a, int l, unsigned char* lds_raw, const int g_wave) {
    unsigned char* ws = a.ws;
    int tid_ = THREAD_ID(); asm volatile("" : "+v"(tid_));
    const int tid = tid_, lane = tid & 63, wid = __builtin_amdgcn_readfirstlane(tid >> 6), fr = lane & 15, fq = lane >> 4;
    const bf16_t* Z = (const bf16_t*)(ws + WS_Z); bf16_t* ZS = (bf16_t*)(ws + WS_ZS);
    const unsigned char* sp = ws + WS_S5P + (size_t)l * S5_LAYER;
    const bf16_t* Bcat = (const bf16_t*)(sp + S5_BCAT); const bf16_t* CmT = (const bf16_t*)(sp + S5_CMT); const float* AA = (const float*)(sp + S5_AA);
    const float* dvec = a.in[14] + l * DS;
    constexpr int TC = 32, NCH = SEQ / TC;
    bf16_t* BUb = (bf16_t*)lds_raw;
    bf16_t* H = (bf16_t*)(lds_raw + 2 * 4 * TC * 136 * 2);
    const bf16x8 zero8 = (bf16x8){0, 0, 0, 0, 0, 0, 0, 0};
    for (int item = blockIdx.x; item < 256; item += gridDim.x) {
        const int b = item >> 4, gq = item & 15;
        __syncthreads();
        if (wid < 4) {
            const f32x2 aa = *(const f32x2*)(AA + ((size_t)(4 * gq + wid) * 64 + lane) * 2);
            const float ar = aa.x, ai = aa.y, nai = -aa.y; float hr = 0.f, hi = 0.f;
#pragma nounroll
            for (int s = 0; s < NCH + 2; ++s) {
                if (s >= 1 && s <= NCH) {
                    const int ch = s - 1;
                    const unsigned* bu = (const unsigned*)(BUb + (size_t)(((ch & 1) * 4 + wid) * TC) * 136) + lane;
                    unsigned* hw = (unsigned*)(H + (size_t)(((ch & 1) * 4 + wid) * TC) * 136) + lane;
                    unsigned v[TC];
#pragma unroll
                    for (int t = 0; t < TC; ++t) v[t] = bu[t * 68];
#pragma unroll
                    for (int t = 0; t < TC; ++t) {
                        const float re = bf_lo(v[t]), im = bf_hi(v[t]); float tr, ti, nr, ni;
                        asm("v_fma_f32 %0, %1, %2, %3" : "=v"(tr) : "v"(nai), "v"(hi), "v"(re));
                        asm("v_fma_f32 %0, %1, %2, %3" : "=v"(ti) : "v"(ai), "v"(hr), "v"(im));
                        asm("v_fma_f32 %0, %1, %2, %3" : "=v"(nr) : "v"(ar), "v"(hr), "v"(tr));
                        asm("v_fma_f32 %0, %1, %2, %3" : "=v"(ni) : "v"(ar), "v"(hi), "v"(ti));
                        hr = nr; hi = ni;
                        hw[t * 68] = cvt_pk_bf16(hr, hi);
                    }
                }
                __syncthreads();
            }
        } else {
            const int gi = wid - 4, g = 4 * gq + gi;
            bf16x8 Bf[8], Cf[4];
#pragma unroll
            for (int nt = 0; nt < 8; ++nt) Bf[nt] = (fq < 2) ? *(const bf16x8*)(Bcat + ((size_t)g * 128 + 16 * nt + fr) * 16 + 8 * fq) : zero8;
#pragma unroll
            for (int k = 0; k < 4; ++k) Cf[k] = *(const bf16x8*)(CmT + ((size_t)g * 16 + fr) * 128 + 32 * k + 8 * fq);
            const f32x4 dv = *(const f32x4*)(dvec + 16 * g + 4 * fq);
            const bf16_t* zx = Z + ((size_t)b * SEQ + fr) * NZ + 2 * DS + 16 * g;
            bf16_t* zo = ZS + ((size_t)b * SEQ + fr) * DS + 16 * g + 4 * fq;
#define S5_LDF(c, mt) (*(const bf16x8*)(zx + (size_t)((c) * TC + 16 * (mt)) * NZ + 8 * (fq & 1)))
#define S5_LDY(c, mt) (*(const u32x2*)(zx + (size_t)((c) * TC + 16 * (mt)) * NZ + 4 * fq))
#define S5_BU1(sv, mt, XFv) do { const bf16x8 xz = (fq < 2) ? XFv : zero8; bf16_t* bw = BUb + (size_t)(((((sv) & 1) * 4 + gi) * TC) + 16 * (mt) + fr) * 136 + 4 * fq; \
        _Pragma("unroll") for (int nt = 0; nt < 8; ++nt) { const f32x4 r = __builtin_amdgcn_mfma_f32_16x16x32_bf16(Bf[nt], xz, (f32x4){0.f, 0.f, 0.f, 0.f}, 0, 0, 0); \
            u32x2 pk; pk.x = cvt_pk_bf16(r.x, r.y); pk.y = cvt_pk_bf16(r.z, r.w); *(u32x2*)(bw + 16 * nt) = pk; } } while (0)
#define S5_Y1(chv, mt, XYv) do { const int ch = (chv); f32x4 y = (f32x4){0.f, 0.f, 0.f, 0.f}; const bf16_t* hrow = H + (size_t)((((ch & 1) * 4 + gi) * TC) + 16 * (mt) + fr) * 136 + 8 * fq; \
        _Pragma("unroll") for (int k = 0; k < 4; ++k) { const bf16x8 hf = *(const bf16x8*)(hrow + 32 * k); y = __builtin_amdgcn_mfma_f32_16x16x32_bf16(Cf[k], hf, y, 0, 0, 0); } \
        const float y0 = y.x + dv.x * bf_lo(XYv.x), y1 = y.y + dv.y * bf_hi(XYv.x), y2 = y.z + dv.z * bf_lo(XYv.y), y3 = y.w + dv.w * bf_hi(XYv.y); \
        u32x2 w; w.x = cvt_pk_bf16(gelu_tanh(y0), gelu_tanh(y1)); w.y = cvt_pk_bf16(gelu_tanh(y2), gelu_tanh(y3)); \
        *(u32x2*)(zo + (size_t)(ch * TC + 16 * (mt)) * DS) = w; } while (0)
            bf16x8 XF0a = S5_LDF(0, 0), XF0b = S5_LDF(0, 1), XF1a = S5_LDF(1, 0), XF1b = S5_LDF(1, 1), XF2a = S5_LDF(2, 0), XF2b = S5_LDF(2, 1), XF3a = S5_LDF(3, 0), XF3b = S5_LDF(3, 1);
            u32x2 XY0a = S5_LDY(0, 0), XY0b = S5_LDY(0, 1), XY1a = S5_LDY(1, 0), XY1b = S5_LDY(1, 1), XY2a = S5_LDY(2, 0), XY2b = S5_LDY(2, 1), XY3a = S5_LDY(3, 0), XY3b = S5_LDY(3, 1);
#define S5_CL(c) (((c) < NCH) ? (c) : NCH - 1)
#define S5_STEP_BU(sv, XFa, XFb) do { S5_BU1(sv, 0, XFa); S5_BU1(sv, 1, XFb); XFa = S5_LDF(S5_CL((sv) + 4), 0); XFb = S5_LDF(S5_CL((sv) + 4), 1); } while (0)
#define S5_STEP_Y(sv, XYa, XYb) do { S5_Y1((sv) - 2, 0, XYa); S5_Y1((sv) - 2, 1, XYb); XYa = S5_LDY(S5_CL((sv) + 2), 0); XYb = S5_LDY(S5_CL((sv) + 2), 1); } while (0)
            S5_STEP_BU(0, XF0a, XF0b); __syncthreads();
            S5_STEP_BU(1, XF1a, XF1b); __syncthreads();
            S5_STEP_BU(2, XF2a, XF2b); S5_STEP_Y(2, XY0a, XY0b); __syncthreads();
            S5_STEP_BU(3, XF3a, XF3b); S5_STEP_Y(3, XY1a, XY1b); __syncthreads();
#pragma nounroll
            for (int s = 4; s < NCH; s += 4) {
                S5_STEP_BU(s, XF0a, XF0b); S5_STEP_Y(s, XY2a, XY2b); __syncthreads();
                S5_STEP_BU(s + 1, XF1a, XF1b); S5_STEP_Y(s + 1, XY3a, XY3b); __syncthreads();
                S5_STEP_BU(s + 2, XF2a, XF2b); S5_STEP_Y(s + 2, XY0a, XY0b); __syncthreads();
                S5_STEP_BU(s + 3, XF3a, XF3b); S5_STEP_Y(s + 3, XY1a, XY1b); __syncthreads();
            }
            S5_Y1(NCH - 2, 0, XY2a); S5_Y1(NCH - 2, 1, XY2b); __syncthreads();
            S5_Y1(NCH - 1, 0, XY3a); S5_Y1(NCH - 1, 1, XY3b); __syncthreads();
#undef S5_CL
#undef S5_STEP_BU
#undef S5_STEP_Y
#undef S5_BU1
#undef S5_Y1
#undef S5_LDF
#undef S5_LDY
        }
    }
    __syncthreads();
}

__device__ __forceinline__ void fixup_phase(const Args& a, int l, const pg8::StaticOrder& S, const int g_wave) {
    unsigned char* ws = a.ws;
    const float* halo = (const float*)(ws + WS_HALO); bf16_t* HID = (bf16_t*)(ws + WS_HID);
    const float* cw = a.in[22] + (size_t)l * 3 * NUP; const float* cb = a.in[23] + (size_t)l * NUP;
    int tid_ = THREAD_ID(); asm volatile("" : "+v"(tid_));
    constexpr int NQ = FF / 4;
    Unit u; int last_pm = -1;
    for (int ui = 0; S.next(ui, u); ++ui) {
      if (u.pm == last_pm) continue;
      last_pm = u.pm;
      for (int q = tid_; q < NQ; q += 512) {
        const int h = 4 * q, pn = h >> 7, tcg = pn * 256 + (h & 127), tcu = tcg + 128;
        const f32x4 w0g = *(const f32x4*)(cw + h), w1g = *(const f32x4*)(cw + NUP + h), w2g = *(const f32x4*)(cw + 2 * NUP + h), bg = *(const f32x4*)(cb + h);
        const f32x4 w0u = *(const f32x4*)(cw + FF + h), w1u = *(const f32x4*)(cw + NUP + FF + h), w2u = *(const f32x4*)(cw + 2 * NUP + FF + h), bu = *(const f32x4*)(cb + FF + h);
        f32x4 a0g[2], a1g[2], p2g[2], p3g[2], a0u[2], a1u[2], p2u[2], p3u[2];
#pragma unroll
        for (int gi = 0; gi < 2; ++gi) {
            const int G = 2 * u.pm + gi; const bool first = (G & 15) == 0;
            const float* hg = halo + (size_t)G * 4 * NUP; const float* hp = first ? hg : hg - (size_t)4 * NUP;
            a0g[gi] = *(const f32x4*)(hg + tcg); a0u[gi] = *(const f32x4*)(hg + tcu);
            a1g[gi] = *(const f32x4*)(hg + NUP + tcg); a1u[gi] = *(const f32x4*)(hg + NUP + tcu);
            p2g[gi] = *(const f32x4*)(hp + 2 * NUP + tcg); p2u[gi] = *(const f32x4*)(hp + 2 * NUP + tcu);
            p3g[gi] = *(const f32x4*)(hp + 3 * NUP + tcg); p3u[gi] = *(const f32x4*)(hp + 3 * NUP + tcu);
        }
#pragma unroll
        for (int gi = 0; gi < 2; ++gi) {
            const int G = 2 * u.pm + gi; const bool first = (G & 15) == 0;
            const f32x4 z4 = (f32x4){0.f, 0.f, 0.f, 0.f};
            const f32x4 q2g = first ? z4 : p2g[gi], q3g = first ? z4 : p3g[gi], q2u = first ? z4 : p2u[gi], q3u = first ? z4 : p3u[gi];
#pragma unroll
            for (int ri = 0; ri < 2; ++ri) {
                const f32x4 g2 = ri ? a1g[gi] : a0g[gi], g1 = ri ? a0g[gi] : q3g, g0 = ri ? q3g : q2g;
                const f32x4 u2 = ri ? a1u[gi] : a0u[gi], u1 = ri ? a0u[gi] : q3u, u0 = ri ? q3u : q2u;
                const f32x4 cg_ = w2g * g2 + (w1g * g1 + (w0g * g0 + bg)), cu_ = w2u * u2 + (w1u * u1 + (w0u * u0 + bu));
                f32x4 hv;
#pragma unroll
                for (int e = 0; e < 4; ++e) hv[e] = cg_[e] * fast_sigmoid(cg_[e]) * cu_[e];
                u32x2 w; w.x = cvt_pk_bf16(hv.x, hv.y); w.y = cvt_pk_bf16(hv.z, hv.w);
                *(u32x2*)(HID + (size_t)(G * 128 + ri) * FF + h) = w;
            }
        }
      }
    }
    asm volatile("s_waitcnt vmcnt(0)" ::: "memory");
    __syncthreads();
}

__device__ __forceinline__ void final_phase(const Args& a, const float* st, const bf16_t* X, const int g_wave) {
    int tid_ = THREAD_ID(); asm volatile("" : "+v"(tid_));
    const int lane = tid_ & 63, wave = tid_ >> 6;
    const int gw = blockIdx.x * 8 + wave, NGW = gridDim.x * 8;
    const float* gf = a.in[28];
    f32x4 g0[4], g1[4];
#pragma unroll
    for (int j = 0; j < 4; ++j) { g0[j] = *(const f32x4*)(gf + 512 * j + 8 * lane); g1[j] = *(const f32x4*)(gf + 512 * j + 8 * lane + 4); }
    for (int row0 = gw; row0 < MTOK; row0 += 4 * NGW) {
        float s[4]; u32x4 xv[4][4];
#pragma unroll
        for (int q = 0; q < 4; ++q) { const int row = row0 + q * NGW; const bool ok = row < MTOK; const int r = ok ? row : row0;
            s[q] = (lane < 32) ? st[(size_t)r * 32 + lane] : 0.f;
            const u32x4* xr = (const u32x4*)(X + (size_t)r * DM) + lane;
#pragma unroll
            for (int j = 0; j < 4; ++j) xv[q][j] = xr[64 * j]; }
#pragma unroll
        for (int q = 0; q < 4; ++q) { const int row = row0 + q * NGW; if (row >= MTOK) continue;
            const float rs = __builtin_amdgcn_rsqf(wave_sum(s[q]) * (1.0f / DM) + EPS);
            float* orow = a.out + (size_t)row * DM + 8 * lane;
#pragma unroll
            for (int j = 0; j < 4; ++j) { f32x4 v0, v1; unpack8(xv[q][j], v0, v1);
                *(f32x4*)(orow + 512 * j) = v0 * rs * g0[j]; *(f32x4*)(orow + 512 * j + 4) = v1 * rs * g1[j]; } }
    }
}

template <int MODE> __device__ __forceinline__ void fill_tab(float* tab, const pg8::StaticOrder& S, const float* st, const float* st2, const int g_wave) {
    int tid_ = THREAD_ID(); asm volatile("" : "+v"(tid_));
    constexpr int NB = (MODE == 0) ? 4 : 2;
    for (int base = tid_; ; base += NB * 512) {
        Unit u; int row[NB]; bool ok[NB]; f32x4 p[NB][8]; f32x4 q[NB][4];
#pragma unroll
        for (int b = 0; b < NB; ++b) { const int idx = base + b * 512; ok[b] = S.next(idx >> 8, u); row[b] = ok[b] ? u.pm * 256 + (idx & 255) : 0;
            const f32x4* sp = (const f32x4*)(st + (size_t)row[b] * 32);
#pragma unroll
            for (int j = 0; j < 8; ++j) p[b][j] = sp[j];
            if (MODE == 1) { const f32x4* sq = (const f32x4*)(st2 + (size_t)row[b] * 16);
#pragma unroll
                for (int j = 0; j < 4; ++j) q[b][j] = sq[j]; } }
        if (!ok[0]) break;
#pragma unroll
        for (int b = 0; b < NB; ++b) { if (!ok[b]) continue; const int idx = base + b * 512;
            float s = 0.f;
#pragma unroll
            for (int j = 0; j < 8; ++j) s += (p[b][j].x + p[b][j].y) + (p[b][j].z + p[b][j].w);
            if (MODE == 0) tab[idx] = __builtin_amdgcn_rsqf(s * (1.0f / DM) + EPS);
            else { float s2 = 0.f;
#pragma unroll
                for (int j = 0; j < 4; ++j) s2 += (q[b][j].x + q[b][j].y) + (q[b][j].z + q[b][j].w);
                const float ra = __builtin_amdgcn_rsqf(s * (1.0f / DS) + EPS), rb = __builtin_amdgcn_rsqf(s2 * (1.0f / DS) + EPS);
                tab[idx] = ra / rb; tab[1024 + idx] = rb; } }
    }
    __syncthreads();
}

#define XB_TMO      128
#define XB_XCNT(j)  (256  + 64 * (j))
#define XB_XSUB(j)  (1280 + 64 * (j))
#define XB_XGEN(j)  (2304 + 64 * (j))
#define XB_TOP      3328
#define XB_TOPGEN   3392
#define XCD_BAR_WORDS 3456
#define XB_SPIN_CAP (1u << 18)
__device__ __forceinline__ unsigned xb_ld(unsigned* p)              { return __hip_atomic_load(p, __ATOMIC_RELAXED, __HIP_MEMORY_SCOPE_AGENT); }
__device__ __forceinline__ unsigned xb_add(unsigned* p, unsigned v) { return __hip_atomic_fetch_add(p, v, __ATOMIC_RELAXED, __HIP_MEMORY_SCOPE_AGENT); }
__device__ __forceinline__ unsigned xb_xcc_id() { return (unsigned)__builtin_amdgcn_s_getreg((3 << 11) | 20) & 0xFu; }
#define XB_SPIN(cond, bar) do { unsigned _sp = 0; while (cond) { __builtin_amdgcn_s_sleep(1); \
    if ((++_sp & 255u) == 0u) { if (xb_ld(&(bar)[XB_TMO])) break; if (_sp > XB_SPIN_CAP) { atomicAdd(&(bar)[XB_TMO], 1u); break; } } } } while (0)
struct XcdBarrier { unsigned* bar; unsigned x; volatile LAS unsigned* st; };
__device__ __forceinline__ XcdBarrier xcd_barrier_post(unsigned* bar, volatile LAS unsigned* st, const int g_wave) {
    XcdBarrier b; b.bar = bar; b.x = xb_xcc_id(); b.st = st;
    if (THREAD_ID() == 0) (void)xb_add(&bar[XB_XCNT(b.x)], 1u);
    return b;
}
__device__ __forceinline__ void xcd_barrier_complete(unsigned* bar, unsigned x, unsigned& nloc, unsigned& nx) {
    const unsigned G = gridDim.x * gridDim.y * gridDim.z;
    unsigned sum, cnt, mine, sp = 0u;
    for (;;) {
        sum = 0u; cnt = 0u; mine = 0u;
#pragma unroll
        for (unsigned j = 0; j < 16; ++j) { const unsigned c = xb_ld(&bar[XB_XCNT(j)]); sum += c; cnt += (c > 0u) ? 1u : 0u; mine = (j == x) ? c : mine; }
        if (sum == G) break;
        __builtin_amdgcn_s_sleep(1);
        if ((++sp & 255u) == 0u) { if (xb_ld(&bar[XB_TMO])) break; if (sp > XB_SPIN_CAP) { atomicAdd(&bar[XB_TMO], 1u); break; } }
    }
    nloc = mine > 0u ? mine : 1u; nx = cnt > 0u ? cnt : 1u;
}
__device__ __forceinline__ void xcd_barrier(const XcdBarrier& b, const int g_wave) {
    asm volatile("s_waitcnt vmcnt(0)" ::: "memory");
    __syncthreads();
    if (THREAD_ID() == 0) {
        unsigned* bar = b.bar;
        __builtin_amdgcn_s_waitcnt(0);
        unsigned nloc = b.st[0], nx = b.st[1];
        if (nloc == 0u) { xcd_barrier_complete(bar, b.x, nloc, nx); b.st[0] = nloc; b.st[1] = nx; }
        const unsigned old = xb_add(&bar[XB_XSUB(b.x)], 1u);
        const unsigned gen = old / nloc;
        if (old + 1u == (gen + 1u) * nloc) {
            __builtin_amdgcn_fence(__ATOMIC_RELEASE, "agent");
            asm volatile("s_waitcnt vmcnt(0)" ::: "memory");
            const unsigned og = xb_add(&bar[XB_TOP], 1u);
            const unsigned tg = og / nx;
            if (og + 1u == (tg + 1u) * nx) xb_add(&bar[XB_TOPGEN], 1u);
            else XB_SPIN(xb_ld(&bar[XB_TOPGEN]) == tg, bar);
            __builtin_amdgcn_fence(__ATOMIC_ACQUIRE, "agent");
            xb_add(&bar[XB_XGEN(b.x)], 1u);
            asm volatile("s_waitcnt vmcnt(0)" ::: "memory");
        } else {
            XB_SPIN(xb_ld(&bar[XB_XGEN(b.x)]) == gen, bar);
            __builtin_amdgcn_fence(__ATOMIC_ACQUIRE, "agent");
            asm volatile("s_waitcnt vmcnt(0)" ::: "memory");
        }
    }
    __syncthreads();
}

__global__ void __launch_bounds__(512, 2) fwd_kernel(Args a0) {
    extern __shared__ __attribute__((aligned(16))) unsigned char lds_raw[];
    LAS unsigned char* lds = (LAS unsigned char*)lds_raw;
    cg::grid_group grid = cg::this_grid();
    float* tabg = (float*)(lds_raw + LDS_RING); const LAS float* tabl = (const LAS float*)(lds + LDS_RING);
    const int ph_hi = a0.ph_hi;
    const int g_wave = __builtin_amdgcn_readfirstlane((int)threadIdx.x >> 6);
    if (THREAD_ID() < 16) ((volatile LAS unsigned*)(lds + LDS_MISC))[THREAD_ID()] = 0u;
    __syncthreads();
    (void)xcd_barrier_post((unsigned*)(a0.ws + WS_CTL), (volatile LAS unsigned*)(lds + LDS_MISC), g_wave);
#pragma nounroll
    for (int ph = a0.ph_lo; ph < ph_hi; ++ph) {
#if defined(__HIP_DEVICE_COMPILE__)
        const __attribute__((address_space(4))) Args* ap = (const __attribute__((address_space(4))) Args*)__builtin_amdgcn_kernarg_segment_ptr();
        asm volatile("" : "+s"(ap));
        Args a;
#pragma unroll
        for (int i = 0; i < 29; ++i) a.in[i] = ap->in[i];
        a.out = ap->out; a.ws = ap->ws; a.ph_lo = 0; a.ph_hi = 0;
#else
        const Args a = a0;
#endif
        unsigned char* ws = a.ws;
        int G = gridDim.x, cblk = blockIdx.x; asm volatile("" : "+s"(G), "+s"(cblk));
        if (ph == 0) {
            if constexpr (PHON(8)) for (int rep = 0; rep < DUPN(8); ++rep) { prologue(a, lds_raw, g_wave); __syncthreads(); }
        } else if (ph == 15) {
            if constexpr (PHON(9)) final_phase(a, (const float*)(ws + WS_ST0), (const bf16_t*)(ws + WS_XB), g_wave);
        } else {
            const int l = (ph - 1) / 7, s = (ph - 1) % 7;
            unsigned char* wl = ws + WS_W + (size_t)l * W_LAYER;
            float* stA = (float*)(ws + (l == 0 ? WS_ST0 : WS_ST1));
            float* stB = (float*)(ws + (l == 0 ? WS_ST1 : WS_ST0));
            bf16_t* XP = (bf16_t*)(ws + (l == 0 ? WS_XB : WS_PROJ));
            bf16_t* XQ = (bf16_t*)(ws + (l == 0 ? WS_PROJ : WS_XB));
            pg8::StaticOrder S;
            if (s == 0) {  if constexpr (PHON(0)) {
                pg8::Gemm g{XP, (const bf16_t*)(wl + W_IN), MTOK, NZ, DM}; S.init(MTOK, NZ, G, cblk);
                fill_tab<0>(tabg, S, stA, nullptr, g_wave);
                EpiWin E{tabl, (bf16_t*)(ws + WS_Z), (float*)(ws + WS_VST)};
                for (int rep = 0; rep < DUPN(0); ++rep) pg8::gemm_phase<EpiWin>(lds, g, S, E, g_wave); }
            } else if (s == 1) {  if constexpr (PHON(1)) {
                for (int rep = 0; rep < DUPN(1); ++rep) { sgu_phase(a, l, lds_raw, g_wave); __syncthreads(); }
                for (int rep = 0; rep < DUPN(10); ++rep) { s5_phase(a, l, lds_raw, g_wave); __syncthreads(); } }
            } else if (s == 2) {  if constexpr (PHON(2)) {
                pg8::Gemm g{(const bf16_t*)(ws + WS_ZS), (const bf16_t*)(wl + W_GLU), MTOK, DS, DS}; S.init(MTOK, DS, G, cblk);
                EpiGlu E{(const bf16_t*)(ws + WS_ZS), a.in[16] + l * DS, (bf16_t*)(ws + WS_MIX), (float*)(ws + WS_YBST)};
                for (int rep = 0; rep < DUPN(2); ++rep) pg8::gemm_phase<EpiGlu>(lds, g, S, E, g_wave); }
            } else if (s == 3) {  if constexpr (PHON(3)) {
                pg8::Gemm g{(const bf16_t*)(ws + WS_MIX), (const bf16_t*)(wl + W_OUT), MTOK, DM, DM}; S.init(MTOK, DM, G, cblk);
                fill_tab<1>(tabg, S, (const float*)(ws + WS_YAST), (const float*)(ws + WS_YBST), g_wave);
                EpiWout E{tabl, XP, stB};
                pg8::gemm_phase<EpiWout>(lds, g, S, E, g_wave); }
            } else if (s == 4) {  if constexpr (PHON(4)) {
                { pg8::Gemm g{XP, (const bf16_t*)(wl + W_UP), MTOK, NUP, DM}; S.init(MTOK, NUP, G, cblk);
                  fill_tab<0>(tabg, S, stB, nullptr, g_wave);
                  EpiUp E{tabl, a.in[22] + (size_t)l * 3 * NUP, a.in[23] + (size_t)l * NUP, (bf16_t*)(ws + WS_HID), (float*)(ws + WS_HALO)};
                  for (int rep = 0; rep < DUPN(4); ++rep) pg8::gemm_phase<EpiUp>(lds, g, S, E, g_wave); }
                { pg8::Gemm g{(const bf16_t*)(ws + WS_PB) + (size_t)l * MTOK * DP, (const bf16_t*)(wl + W_PROJ), MTOK, DM, DP}; S.init(MTOK, DM, G, cblk);
                  EpiProj E{XQ};
                  for (int rep = 0; rep < DUPN(5); ++rep) pg8::gemm_phase<EpiProj>(lds, g, S, E, g_wave); } }
            } else if (s == 5) {  if constexpr (PHON(6)) {
                pg8::Gemm g{(const bf16_t*)(ws + WS_HID), (const bf16_t*)(wl + W_DOWN), MTOK, DM, FF}; S.init(MTOK, DM, G, cblk);
                fixup_phase(a, l, S, g_wave);
                EpiDown E{XP, stA};
                pg8::gemm_phase<EpiDown>(lds, g, S, E, g_wave); }
            } else {  if constexpr (PHON(7)) {
                pg8::Gemm g{XP, (const bf16_t*)(wl + W_GATE), MTOK, DM, DM}; S.init(MTOK, DM, G, cblk);
                fill_tab<0>(tabg, S, stA, nullptr, g_wave);
                EpiGate E{tabl, XP, XQ, stB};
                pg8::gemm_phase<EpiGate>(lds, g, S, E, g_wave); }
            }
        }
#ifndef EXTRA_SYNCS
#define EXTRA_SYNCS 0
#endif
        if (ph + 1 < ph_hi) {
            if (ph_hi > 1000) grid.sync();
            XcdBarrier xb; xb.bar = (unsigned*)(ws + WS_CTL); xb.x = xb_xcc_id(); xb.st = (volatile LAS unsigned*)(lds + LDS_MISC);
            xcd_barrier(xb, g_wave); for (int e = 0; e < EXTRA_SYNCS; ++e) xcd_barrier(xb, g_wave);
        }
    }
}

extern "C" void kernel_launch(void* const* d_in, const int* in_sizes, int n_in, void* d_out, int out_size, void* d_ws, size_t ws_size, hipStream_t stream) {
    static int grid = 0;
    if (grid == 0) {
        if (n_in != 29 || ws_size < WS_END) { fprintf(stderr, "kernel_launch: unexpected n_in %d / ws_size %zu\n", n_in, ws_size); grid = -1; return; }
        int dev = 0, cus = 0, per_cu = 0;
        hipGetDevice(&dev);
        hipDeviceGetAttribute(&cus, hipDeviceAttributeMultiprocessorCount, dev);
        if (hipFuncSetAttribute((const void*)fwd_kernel, hipFuncAttributeMaxDynamicSharedMemorySize, LDS_BYTES) != hipSuccess) { fprintf(stderr, "kernel_launch: hipFuncSetAttribute failed\n"); grid = -1; return; }
        hipOccupancyMaxActiveBlocksPerMultiprocessor(&per_cu, (const void*)fwd_kernel, 512, LDS_BYTES);
        (void)hipGetLastError();
        if (per_cu < 1) per_cu = 1;
        grid = cus * 1;
        if (grid <= 0) grid = 256;
    }
    if (grid < 0) return;
    if (hipMemsetAsync((char*)d_ws + WS_CTL, 0, CTL_BYTES, stream) != hipSuccess) { fprintf(stderr, "kernel_launch: memset of the barrier words failed\n"); return; }
    Args a{};
    for (int i = 0; i < 29; ++i) a.in[i] = (const float*)d_in[i];
    a.out = (float*)d_out; a.ws = (unsigned char*)d_ws;
#if MULTI_LAUNCH
    for (int ph = 0; ph < 16; ++ph) {
        a.ph_lo = ph; a.ph_hi = ph + 1;
        hipLaunchKernelGGL(fwd_kernel, dim3(grid), dim3(512), LDS_BYTES, stream, a);
    }
#else
    a.ph_lo = 0; a.ph_hi = 16;
    void* args[] = {&a};
    hipError_t e = hipLaunchCooperativeKernel((const void*)fwd_kernel, dim3(grid), dim3(512), args, LDS_BYTES, stream);
    if (e != hipSuccess) fprintf(stderr, "cooperative launch failed: %s (grid %d)\n", hipGetErrorString(e), grid);
#endif
}
```

```cpp
#include <hip/hip_runtime.h>
#include <hip/hip_cooperative_groups.h>
#include <cstdio>
#include <cstdint>
namespace cg = cooperative_groups;

#ifndef MULTI_LAUNCH
#define MULTI_LAUNCH 0
#endif
#ifndef PH_MASK
#define PH_MASK 0x3FF
#endif
#define PHON(k) (((PH_MASK) >> (k)) & 1)
#ifndef DUP_MASK
#define DUP_MASK 0
#endif
#define DUPN(k) ((((DUP_MASK) >> (k)) & 1) ? 2 : 1)

#define LAS __attribute__((address_space(3)))
typedef unsigned short bf16_t;
typedef short bf16x8 __attribute__((ext_vector_type(8)));
typedef float f32x4 __attribute__((ext_vector_type(4)));
typedef float f32x2 __attribute__((ext_vector_type(2)));
typedef unsigned u32x4 __attribute__((ext_vector_type(4)));
typedef unsigned u32x2 __attribute__((ext_vector_type(2)));

constexpr int MTOK = 32768, SEQ = 2048, DM = 2048, NZ = 3072, DS = 1024, FF = 5632, NUP = 11264, DP = 256;
constexpr float EPS = 1e-6f;
constexpr size_t MiB = 1u << 20;
constexpr size_t WS_ST0 = 0, WS_ST1 = 4 * MiB, WS_VST = 8 * MiB, WS_YAST = 12 * MiB, WS_YBST = 16 * MiB, WS_S5P = 18 * MiB, WS_SGUW = 20 * MiB, WS_HALO = 22 * MiB;
constexpr size_t WS_W = 66 * MiB;
constexpr size_t W_IN = 0, W_GLU = 12 * MiB, W_OUT = 14 * MiB, W_UP = 22 * MiB, W_DOWN = 66 * MiB, W_GATE = 88 * MiB, W_PROJ = 96 * MiB, W_LAYER = 97 * MiB;
constexpr size_t WS_PB = 260 * MiB;
constexpr size_t WS_XB = 292 * MiB;
constexpr size_t WS_BIG = 420 * MiB;
constexpr size_t WS_Z = WS_BIG, WS_ZS = WS_BIG + 192 * MiB, WS_MIX = WS_BIG + 256 * MiB, WS_HID = WS_BIG;
constexpr size_t WS_PROJ = 804 * MiB;
constexpr size_t WS_CTL = 932 * MiB, CTL_BYTES = 16384;
constexpr size_t WS_END = 933 * MiB;
constexpr size_t S5_BCAT = 0, S5_CMT = 256 * 1024, S5_AA = 512 * 1024, S5_LAYER = 1 * MiB;

constexpr int LDS_RING = 131072, LDS_TAB = 24576, LDS_MISC = LDS_RING + LDS_TAB, LDS_BYTES = LDS_MISC + 64;

typedef __bf16 bf16x2_t __attribute__((ext_vector_type(2)));
__device__ __forceinline__ unsigned cvt_pk_bf16(float lo, float hi) { const f32x2 v = {lo, hi}; const bf16x2_t b = __builtin_convertvector(v, bf16x2_t); return __builtin_bit_cast(unsigned, b); }
__device__ __forceinline__ float bf_lo(unsigned u) { return __uint_as_float(u << 16); }
__device__ __forceinline__ float bf_hi(unsigned u) { return __uint_as_float(u & 0xffff0000u); }
__device__ __forceinline__ float fast_sigmoid(float x) { return __builtin_amdgcn_rcpf(1.0f + __builtin_amdgcn_exp2f(-1.44269504089f * x)); }
__device__ __forceinline__ float gelu_tanh(float x) {
    const float t = x * x;
    const float e = __builtin_amdgcn_exp2f(x * __builtin_fmaf(t, -0.10294324f, -2.30220818f));
    return x * __builtin_amdgcn_rcpf(1.0f + e);
}
__device__ __forceinline__ unsigned lnd(unsigned x) { asm volatile("" : "+v"(x)); return x; }
__device__ __forceinline__ int lane_id() { int z; asm volatile("v_mbcnt_lo_u32_b32 %0, -1, 0\n\tv_mbcnt_hi_u32_b32 %0, -1, %0" : "=v"(z)); return z; }
#define THREAD_ID() (g_wave * 64 + lane_id())
__device__ __forceinline__ float wave_sum(float v) {
#pragma unroll
    for (int o = 1; o < 64; o <<= 1) v += __shfl_xor(v, o);
    return v;
}
__device__ __forceinline__ float red_fq(float s) { s += __shfl_xor(s, 16); s += __shfl_xor(s, 32); return s; }
__device__ __forceinline__ float slots_sum32(const float* slots, int row) {
    const f32x4* p = (const f32x4*)(slots + (size_t)row * 32); float s = 0.f;
#pragma unroll
    for (int j = 0; j < 8; ++j) { const f32x4 q = p[j]; s += (q.x + q.y) + (q.z + q.w); }
    return s;
}
__device__ __forceinline__ float slots_sum16(const float* slots, int row) {
    const f32x4* p = (const f32x4*)(slots + (size_t)row * 16); float s = 0.f;
#pragma unroll
    for (int j = 0; j < 4; ++j) { const f32x4 q = p[j]; s += (q.x + q.y) + (q.z + q.w); }
    return s;
}

namespace pg8 {
constexpr int BM = 256, BK = 64, HALF = 128, HTB = HALF * BK * 2, STAGE_BYTES = 8 * HTB, NXCD = 8, WGM = 8;
__host__ __device__ __forceinline__ int lds_byte(int r, int c) { const int st = (r >> 4) * 2 + (c >> 5), rr = r & 15, cc = c & 31, ob = rr * 64 + cc * 2; return st * 1024 + (ob ^ (((ob >> 9) & 1) << 5)); }
__host__ __device__ __forceinline__ void stage_rc(int b, int& R, int& C) { const int st = b / 1024, sb = b % 1024, swz = sb ^ (((sb >> 9) & 1) << 5); R = (st >> 1) * 16 + swz / 64; C = (st & 1) * 32 + (swz % 64) / 2; }
__host__ __device__ __forceinline__ int perm32(int rho) { const int n = rho >> 4, i = rho & 15; return 8 * (i >> 2) + 4 * n + (i & 3); }

struct Unit { int pm, pn; };
struct Gemm { const bf16_t* A; const bf16_t* Bt; int M, N, K; };

struct StaticOrder {
    int nM, nN, nwg, G, c;
    __device__ void init(int M, int N, int G_, int c_) { nM = M / BM; nN = N / BM; nwg = nM * nN; G = G_; c = c_; }
    __device__ bool next(int i, Unit& u) const {
        const long L = (long)i * G + c; if (L >= nwg) return false;
        int wgid = (int)L; { const int q = nwg / NXCD, r = nwg % NXCD, xcd = wgid % NXCD, off = wgid / NXCD; wgid = (xcd < r ? xcd * (q + 1) : r * (q + 1) + (xcd - r) * q) + off; }
        const int nig = WGM * nN, gid = wgid / nig, fm = gid * WGM, gsz = (nM - fm) < WGM ? (nM - fm) : WGM;
        u.pm = fm + ((wgid % nig) % gsz); u.pn = (wgid % nig) / gsz; return true;
    }
};

template <bool ROWPERM> __device__ __forceinline__ int epi_row(const Unit& u, int ai, int m, int wr, int fr) {
    return ROWPERM ? (u.pm * BM + 128 * wr + 8 * fr + 4 * ai + m) : (u.pm * BM + 128 * ai + 64 * wr + 16 * m + fr);
}

template <class Epi>
__device__ __forceinline__ void gemm_phase(LAS unsigned char* lds, const Gemm g, const StaticOrder& S, const Epi& E, const int g_wave) {
    constexpr bool ROWPERM = Epi::ROWPERM;
    int tid_ = THREAD_ID(); asm volatile("" : "+v"(tid_));
    const int tid = tid_, wid = __builtin_amdgcn_readfirstlane(tid >> 6), lane = tid & 63, wr = wid >> 2, wc = wid & 3, fr = lane & 15, fq = lane >> 4;
    const int K = g.K, nt = K / BK;
    unsigned voffA[2], voffB[2];
#pragma unroll
    for (int i = 0; i < 2; ++i) { int R, C; stage_rc(tid * 16 + i * 8192, R, C); const int Rb = (R & ~31) + perm32(R & 31);
        const int Ra = ROWPERM ? (128 * (R >> 6) + 8 * (R & 15) + ((R >> 4) & 3)) : R;
        voffA[i] = (unsigned)(Ra * K + C) * 2u; voffB[i] = (unsigned)(Rb * K + C) * 2u; }
    const size_t kstep = (size_t)(BK * 2);
    const size_t hstepB = (size_t)HALF * K * 2;
    const size_t hstepA = ROWPERM ? (size_t)4 * K * 2 : hstepB;
    const size_t tstep = 2 * hstepB;
    const unsigned ldsw = (unsigned)wid * 1024u;
    const int aoff = lds_byte(wr * 64 + fr, fq * 8), boff = lds_byte(wc * 32 + fr, fq * 8);
#define PG8_SA(b, h) (((b) * 2 + (h)) * HTB)
#define PG8_SB(b, h) ((4 + (b) * 2 + (h)) * HTB)
#define PG8_STAGE(bufoff, gbase, voff) do { _Pragma("unroll") for (int _i = 0; _i < 2; ++_i) \
        __builtin_amdgcn_global_load_lds((const unsigned*)((const char*)(gbase) + (voff)[_i]), (LAS unsigned*)(lds + (bufoff) + ldsw + _i * 8192), 16, 0, 0); } while (0)
#define PG8_LDA(dst, b, h) do { _Pragma("unroll") for (int m = 0; m < 4; ++m) _Pragma("unroll") for (int k = 0; k < 2; ++k) dst[m][k] = *(const LAS bf16x8*)(lds + PG8_SA(b, h) + aoff + m * 2048 + k * 1024); } while (0)
#define PG8_LDB(dst, b, h) do { _Pragma("unroll") for (int n = 0; n < 2; ++n) _Pragma("unroll") for (int k = 0; k < 2; ++k) dst[n][k] = *(const LAS bf16x8*)(lds + PG8_SB(b, h) + boff + n * 2048 + k * 1024); } while (0)
#define PG8_MMA(ai, bj, At, Bt) do { __builtin_amdgcn_s_setprio(1); _Pragma("unroll") for (int m = 0; m < 4; ++m) _Pragma("unroll") for (int n = 0; n < 2; ++n) _Pragma("unroll") for (int k = 0; k < 2; ++k) \
        acc[ai][bj][m][n] = __builtin_amdgcn_mfma_f32_16x16x32_bf16(Bt[n][k], At[m][k], acc[ai][bj][m][n], 0, 0, 0); __builtin_amdgcn_s_setprio(0); } while (0)
#define PG8_WAIT_V(n) asm volatile("s_waitcnt vmcnt(" #n ")" ::: "memory")
#define PG8_WAIT_L(n) asm volatile("s_waitcnt lgkmcnt(" #n ")" ::: "memory")
#define PG8_BAR __builtin_amdgcn_s_barrier()
#define PG8_SCHED __builtin_amdgcn_sched_barrier(0)
    Unit cur, nxt; int ui = 0;
    if (!S.next(0, cur)) return;
    f32x4 acc[2][2][4][2];
#pragma unroll
    for (int a = 0; a < 2; ++a)
#pragma unroll
        for (int b = 0; b < 2; ++b)
#pragma unroll
            for (int m = 0; m < 4; ++m)
#pragma unroll
                for (int n = 0; n < 2; ++n) acc[a][b][m][n] = (f32x4){0.f, 0.f, 0.f, 0.f};
    bf16x8 At[4][2], B0[2][2], B1[2][2];
    const char* cA = (const char*)g.A + (size_t)cur.pm * tstep; const char* cB = (const char*)g.Bt + (size_t)cur.pn * tstep;
    PG8_STAGE(PG8_SB(0, 0), cB, voffB); PG8_STAGE(PG8_SB(0, 1), cB + hstepB, voffB); PG8_STAGE(PG8_SA(0, 0), cA, voffA); PG8_STAGE(PG8_SA(0, 1), cA + hstepA, voffA);
    if (wr == 1) PG8_BAR;
    PG8_WAIT_V(2); PG8_BAR;
    PG8_STAGE(PG8_SB(1, 0), cB + kstep, voffB); PG8_STAGE(PG8_SA(1, 0), cA + kstep, voffA); PG8_STAGE(PG8_SB(1, 1), cB + hstepB + kstep, voffB);
    PG8_WAIT_V(6); PG8_BAR;
    for (;;) {
        const bool has_next = S.next(ui + 1, nxt);
        const char* nA = has_next ? (const char*)g.A + (size_t)nxt.pm * tstep : cA; const char* nB = has_next ? (const char*)g.Bt + (size_t)nxt.pn * tstep : cB;
#pragma nounroll
        for (int t = 0; t < nt; t += 2) {
            const bool last = (t == nt - 2);
            const char* a1 = cA + (size_t)(t + 1) * kstep;
            const char* a2 = last ? nA : cA + (size_t)(t + 2) * kstep; const char* b2 = last ? nB : cB + (size_t)(t + 2) * kstep;
            const char* a3 = a2 + kstep; const char* b3 = b2 + kstep;
            if constexpr (Epi::MIDK) { if (t == (nt >> 1)) E.mid(acc, cur, ui, wr, wc, fr, fq); }
            const bool relax = (t == 0) && (ui > 0);
            PG8_LDB(B0, 0, 0); PG8_LDB(B1, 0, 1); PG8_SCHED; PG8_LDA(At, 0, 0); if (!relax) PG8_STAGE(PG8_SA(1, 1), a1 + hstepA, voffA);
            if (relax) PG8_WAIT_V(22); else PG8_WAIT_V(8);
            PG8_WAIT_L(0); PG8_BAR; PG8_MMA(0, 0, At, B0); PG8_MMA(0, 1, At, B1); PG8_BAR; PG8_SCHED;
            PG8_LDA(At, 0, 1); PG8_STAGE(PG8_SB(0, 0), b2, voffB); PG8_STAGE(PG8_SB(0, 1), b2 + hstepB, voffB); PG8_STAGE(PG8_SA(0, 0), a2, voffA);
            if (relax) PG8_WAIT_V(22); else PG8_WAIT_V(8);
            PG8_WAIT_L(0); PG8_BAR; PG8_MMA(1, 0, At, B0); PG8_MMA(1, 1, At, B1); PG8_BAR; PG8_SCHED;
            PG8_LDB(B0, 1, 0); PG8_LDB(B1, 1, 1); PG8_SCHED; PG8_LDA(At, 1, 0); PG8_STAGE(PG8_SA(0, 1), a2 + hstepA, voffA);
            if (relax) PG8_WAIT_V(22); else PG8_WAIT_V(8);
            PG8_WAIT_L(0); PG8_BAR; PG8_MMA(0, 0, At, B0); PG8_MMA(0, 1, At, B1); PG8_BAR; PG8_SCHED;
            PG8_LDA(At, 1, 1); PG8_STAGE(PG8_SB(1, 0), b3, voffB); PG8_STAGE(PG8_SB(1, 1), b3 + hstepB, voffB); PG8_STAGE(PG8_SA(1, 0), a3, voffA);
            PG8_WAIT_V(8); PG8_WAIT_L(0); PG8_BAR; PG8_MMA(1, 0, At, B0); PG8_MMA(1, 1, At, B1); PG8_BAR; PG8_SCHED;
        }
        if (has_next) PG8_STAGE(PG8_SA(1, 1), nA + kstep + hstepA, voffA);
        if (wr == 0) PG8_BAR;
        E(acc, cur, ui, wr, wc, fr, fq);
        if (!has_next) break;
#pragma unroll
        for (int a = 0; a < 2; ++a)
#pragma unroll
            for (int b = 0; b < 2; ++b)
#pragma unroll
                for (int m = 0; m < 4; ++m)
#pragma unroll
                    for (int n = 0; n < 2; ++n) acc[a][b][m][n] = (f32x4){0.f, 0.f, 0.f, 0.f};
        cur = nxt; cA = nA; cB = nB; ++ui;
        if (wr == 1) PG8_BAR;
    }
    PG8_WAIT_V(0);
    PG8_BAR;
#undef PG8_SA
#undef PG8_SB
#undef PG8_STAGE
#undef PG8_LDA
#undef PG8_LDB
#undef PG8_MMA
#undef PG8_WAIT_V
#undef PG8_WAIT_L
#undef PG8_BAR
#undef PG8_SCHED
}
}
using pg8::Unit;
typedef f32x4 AccT[2][2][4][2];

__device__ __forceinline__ void unpack8(const u32x4 w, f32x4& v0, f32x4& v1) {
    v0.x = bf_lo(w.x); v0.y = bf_hi(w.x); v0.z = bf_lo(w.y); v0.w = bf_hi(w.y); v1.x = bf_lo(w.z); v1.y = bf_hi(w.z); v1.z = bf_lo(w.w); v1.w = bf_hi(w.w);
}
__device__ __forceinline__ void store_x8(bf16_t* xb, size_t off, const f32x4 v0, const f32x4 v1, float& ssq) {
    u32x4 w; w.x = cvt_pk_bf16(v0.x, v0.y); w.y = cvt_pk_bf16(v0.z, v0.w); w.z = cvt_pk_bf16(v1.x, v1.y); w.w = cvt_pk_bf16(v1.z, v1.w);
    *(u32x4*)(xb + off) = w;
    ssq += ((v0.x * v0.x + v0.y * v0.y) + (v0.z * v0.z + v0.w * v0.w)) + ((v1.x * v1.x + v1.y * v1.y) + (v1.z * v1.z + v1.w * v1.w));
}

struct EpiWin {
    static constexpr bool ROWPERM = false, MIDK = false;
    const LAS float* tab; bf16_t* Z; float* vst;
    __device__ __forceinline__ void operator()(AccT& acc, const Unit& u, int ui, int wr, int wc, int fr, int fq) const {
        const int col0 = u.pn * 256 + 32 * wc + 8 * fq; const int sect = u.pn >> 2;
#pragma unroll
        for (int ai = 0; ai < 2; ++ai)
#pragma unroll
            for (int m = 0; m < 4; ++m) {
                const int row = pg8::epi_row<false>(u, ai, m, wr, fr);
                const float rs = tab[ui * 256 + (row & 255)];
                float s1 = 0.f, s2 = 0.f;
#pragma unroll
                for (int bj = 0; bj < 2; ++bj) {
                    f32x4 v0 = acc[ai][bj][m][0] * rs, v1 = acc[ai][bj][m][1] * rs;
                    if (sect < 2) {
#pragma unroll
                        for (int j = 0; j < 4; ++j) { v0[j] = gelu_tanh(v0[j]); v1[j] = gelu_tanh(v1[j]); }
                    }
                    if (sect == 1) {
                        s1 += ((v0.x + v0.y) + (v0.z + v0.w)) + ((v1.x + v1.y) + (v1.z + v1.w));
                        s2 += ((v0.x * v0.x + v0.y * v0.y) + (v0.z * v0.z + v0.w * v0.w)) + ((v1.x * v1.x + v1.y * v1.y) + (v1.z * v1.z + v1.w * v1.w));
                    }
                    u32x4 w; w.x = cvt_pk_bf16(v0.x, v0.y); w.y = cvt_pk_bf16(v0.z, v0.w); w.z = cvt_pk_bf16(v1.x, v1.y); w.w = cvt_pk_bf16(v1.z, v1.w);
                    *(u32x4*)(Z + (size_t)row * NZ + col0 + 128 * bj) = w;
                }
                if (sect == 1) {
                    s1 = red_fq(s1); s2 = red_fq(s2);
                    if (fq == 0) *(f32x2*)(vst + ((size_t)row * 16 + (u.pn - 4) * 4 + wc) * 2) = (f32x2){s1, s2};
                }
            }
    }
};

struct EpiGlu {
    static constexpr bool ROWPERM = false, MIDK = false;
    const bf16_t* ZS; const float* bias; bf16_t* MIXB; float* ybst;
    __device__ __forceinline__ void operator()(AccT& acc, const Unit& u, int ui, int wr, int wc, int fr, int fq) const {
        const int col0 = u.pn * 256 + 32 * wc + 8 * fq;
#pragma unroll
        for (int ai = 0; ai < 2; ++ai)
#pragma unroll
            for (int m = 0; m < 4; ++m) {
                const int row = pg8::epi_row<false>(u, ai, m, wr, fr);
                float ssq = 0.f;
#pragma unroll
                for (int bj = 0; bj < 2; ++bj) {
                    const int col = col0 + 128 * bj;
                    const u32x4 zz = *(const u32x4*)(ZS + (size_t)row * DS + col);
                    const f32x4 b0 = *(const f32x4*)(bias + col), b1 = *(const f32x4*)(bias + col + 4);
                    const f32x4 a0 = acc[ai][bj][m][0] + b0, a1 = acc[ai][bj][m][1] + b1;
                    float y[8];
                    y[0] = bf_lo(zz.x) * fast_sigmoid(a0.x); y[1] = bf_hi(zz.x) * fast_sigmoid(a0.y); y[2] = bf_lo(zz.y) * fast_sigmoid(a0.z); y[3] = bf_hi(zz.y) * fast_sigmoid(a0.w);
                    y[4] = bf_lo(zz.z) * fast_sigmoid(a1.x); y[5] = bf_hi(zz.z) * fast_sigmoid(a1.y); y[6] = bf_lo(zz.w) * fast_sigmoid(a1.z); y[7] = bf_hi(zz.w) * fast_sigmoid(a1.w);
#pragma unroll
                    for (int j = 0; j < 8; ++j) ssq += y[j] * y[j];
                    u32x4 w; w.x = cvt_pk_bf16(y[0], y[1]); w.y = cvt_pk_bf16(y[2], y[3]); w.z = cvt_pk_bf16(y[4], y[5]); w.w = cvt_pk_bf16(y[6], y[7]);
                    *(u32x4*)(MIXB + (size_t)row * DM + DS + col) = w;
                }
                ssq = red_fq(ssq);
                if (fq == 0) ybst[(size_t)row * 16 + u.pn * 4 + wc] = ssq;
            }
    }
};

struct EpiWout {
    static constexpr bool ROWPERM = false, MIDK = true;
    const LAS float* tab; bf16_t* X; float* stout;
    __device__ __forceinline__ void mid(AccT& acc, const Unit& u, int ui, int wr, int wc, int fr, int fq) const {
#pragma unroll
        for (int ai = 0; ai < 2; ++ai)
#pragma unroll
            for (int m = 0; m < 4; ++m) {
                const int row = pg8::epi_row<false>(u, ai, m, wr, fr);
                const float ratio = tab[ui * 256 + (row & 255)];
#pragma unroll
                for (int bj = 0; bj < 2; ++bj) { acc[ai][bj][m][0] *= ratio; acc[ai][bj][m][1] *= ratio; }
            }
    }
    __device__ __forceinline__ void operator()(AccT& acc, const Unit& u, int ui, int wr, int wc, int fr, int fq) const {
        const int col0 = u.pn * 256 + 32 * wc + 8 * fq;
#pragma unroll
        for (int ai = 0; ai < 2; ++ai) {
            u32x4 xr[4][2];
#pragma unroll
            for (int m = 0; m < 4; ++m)
#pragma unroll
                for (int bj = 0; bj < 2; ++bj) xr[m][bj] = *(const u32x4*)(X + (size_t)pg8::epi_row<false>(u, ai, m, wr, fr) * DM + col0 + 128 * bj);
#pragma unroll
            for (int m = 0; m < 4; ++m) {
                const int row = pg8::epi_row<false>(u, ai, m, wr, fr);
                const float rb = tab[1024 + ui * 256 + (row & 255)];
                float ssq = 0.f;
#pragma unroll
                for (int bj = 0; bj < 2; ++bj) {
                    f32x4 x0, x1; unpack8(xr[m][bj], x0, x1);
                    store_x8(X, (size_t)row * DM + col0 + 128 * bj, x0 + acc[ai][bj][m][0] * rb, x1 + acc[ai][bj][m][1] * rb, ssq);
                }
                ssq = red_fq(ssq);
                if (fq == 0) stout[(size_t)row * 32 + u.pn * 4 + wc] = ssq;
            }
        }
    }
};

struct EpiDown {
    static constexpr bool ROWPERM = false, MIDK = false;
    bf16_t* X; float* stout;
    __device__ __forceinline__ void operator()(AccT& acc, const Unit& u, int ui, int wr, int wc, int fr, int fq) const {
        const int col0 = u.pn * 256 + 32 * wc + 8 * fq;
#pragma unroll
        for (int ai = 0; ai < 2; ++ai) {
            u32x4 xr[4][2];
#pragma unroll
            for (int m = 0; m < 4; ++m)
#pragma unroll
                for (int bj = 0; bj < 2; ++bj) xr[m][bj] = *(const u32x4*)(X + (size_t)pg8::epi_row<false>(u, ai, m, wr, fr) * DM + col0 + 128 * bj);
#pragma unroll
            for (int m = 0; m < 4; ++m) {
                const int row = pg8::epi_row<false>(u, ai, m, wr, fr);
                float ssq = 0.f;
#pragma unroll
                for (int bj = 0; bj < 2; ++bj) {
                    f32x4 x0, x1; unpack8(xr[m][bj], x0, x1);
                    store_x8(X, (size_t)row * DM + col0 + 128 * bj, x0 + acc[ai][bj][m][0], x1 + acc[ai][bj][m][1], ssq);
                }
                ssq = red_fq(ssq);
                if (fq == 0) stout[(size_t)row * 32 + u.pn * 4 + wc] = ssq;
            }
        }
    }
};

struct EpiProj {
    static constexpr bool ROWPERM = false, MIDK = false;
    bf16_t* P;
    __device__ __forceinline__ void operator()(AccT& acc, const Unit& u, int ui, int wr, int wc, int fr, int fq) const {
        const int col0 = u.pn * 256 + 32 * wc + 8 * fq;
#pragma unroll
        for (int ai = 0; ai < 2; ++ai)
#pragma unroll
            for (int m = 0; m < 4; ++m) {
                const int row = pg8::epi_row<false>(u, ai, m, wr, fr);
#pragma unroll
                for (int bj = 0; bj < 2; ++bj) {
                    const f32x4 v0 = acc[ai][bj][m][0], v1 = acc[ai][bj][m][1];
                    u32x4 w; w.x = cvt_pk_bf16(v0.x, v0.y); w.y = cvt_pk_bf16(v0.z, v0.w); w.z = cvt_pk_bf16(v1.x, v1.y); w.w = cvt_pk_bf16(v1.z, v1.w);
                    *(u32x4*)(P + (size_t)row * DM + col0 + 128 * bj) = w;
                }
            }
    }
};

struct EpiGate {
    static constexpr bool ROWPERM = false, MIDK = false;
    const LAS float* tab; const bf16_t* XP; bf16_t* XQ; float* stout;
    __device__ __forceinline__ void operator()(AccT& acc, const Unit& u, int ui, int wr, int wc, int fr, int fq) const {
        const int col0 = u.pn * 256 + 32 * wc + 8 * fq;
#pragma unroll
        for (int ai = 0; ai < 2; ++ai) {
            u32x4 xr[4][2], pr[4][2];
#pragma unroll
            for (int m = 0; m < 4; ++m)
#pragma unroll
                for (int bj = 0; bj < 2; ++bj) { const size_t off = (size_t)pg8::epi_row<false>(u, ai, m, wr, fr) * DM + col0 + 128 * bj;
                    xr[m][bj] = *(const u32x4*)(XP + off); pr[m][bj] = *(const u32x4*)(XQ + off); }
#pragma unroll
            for (int m = 0; m < 4; ++m) {
                const int row = pg8::epi_row<false>(u, ai, m, wr, fr);
                const float rs = tab[ui * 256 + (row & 255)];
                float ssq = 0.f;
#pragma unroll
                for (int bj = 0; bj < 2; ++bj) {
                    f32x4 x0, x1, p0, p1; unpack8(xr[m][bj], x0, x1); unpack8(pr[m][bj], p0, p1);
                    const float rsn = -1.44269504089f * rs;
                    const f32x4 a0 = acc[ai][bj][m][0] * rsn, a1 = acc[ai][bj][m][1] * rsn;
                    f32x4 n0, n1;
#pragma unroll
                    for (int e = 0; e < 4; ++e) { n0[e] = x0[e] + __builtin_amdgcn_rcpf(1.0f + __builtin_amdgcn_exp2f(a0[e])) * p0[e]; n1[e] = x1[e] + __builtin_amdgcn_rcpf(1.0f + __builtin_amdgcn_exp2f(a1[e])) * p1[e]; }
                    store_x8(XQ, (size_t)row * DM + col0 + 128 * bj, n0, n1, ssq);
                }
                ssq = red_fq(ssq);
                if (fq == 0) stout[(size_t)row * 32 + u.pn * 4 + wc] = ssq;
            }
        }
    }
};

struct EpiUp {
    static constexpr bool ROWPERM = true, MIDK = false;
    const LAS float* tab; const float* cw; const float* cb; bf16_t* HID; float* halo;
    __device__ __forceinline__ void conv_inplace(AccT& acc, int bj, int n, const float (&rs)[8], const float* cwp, const float* cbp, float* hp, int fr) const {
        const f32x4 w0 = *(const f32x4*)(cwp), w1 = *(const f32x4*)(cwp + NUP), w2 = *(const f32x4*)(cwp + 2 * NUP), bb = *(const f32x4*)(cbp);
#pragma unroll
        for (int j = 0; j < 8; ++j) acc[j >> 2][bj][j & 3][n] *= rs[j];
        f32x4 p1, p2;
#pragma unroll
        for (int e = 0; e < 4; ++e) { p1[e] = __shfl_up(acc[1][bj][3][n][e], 1, 16); p2[e] = __shfl_up(acc[1][bj][2][n][e], 1, 16); }
        if (fr == 0) { *(f32x4*)(hp) = acc[0][bj][0][n]; *(f32x4*)(hp + NUP) = acc[0][bj][1][n]; }
        if (fr == 15) { *(f32x4*)(hp + 2 * NUP) = acc[1][bj][2][n]; *(f32x4*)(hp + 3 * NUP) = acc[1][bj][3][n]; }
#pragma unroll
        for (int j = 7; j >= 0; --j) {
            const f32x4 m1 = (j >= 1) ? acc[(j - 1 >= 0 ? j - 1 : 0) >> 2][bj][(j - 1 >= 0 ? j - 1 : 0) & 3][n] : p1;
            const f32x4 m2 = (j >= 2) ? acc[(j - 2 >= 0 ? j - 2 : 0) >> 2][bj][(j - 2 >= 0 ? j - 2 : 0) & 3][n] : (j == 1 ? p1 : p2);
            acc[j >> 2][bj][j & 3][n] = w2 * acc[j >> 2][bj][j & 3][n] + (w1 * m1 + (w0 * m2 + bb));
        }
    }
    __device__ __forceinline__ void operator()(AccT& acc, const Unit& u, int ui, int wr, int wc, int fr, int fq) const {
        const int T0 = u.pm * 256 + 128 * wr + 8 * fr;
        const int G = u.pm * 2 + wr;
        const int tc0 = 32 * wc + 8 * fq;
        const int h0 = u.pn * 128 + tc0;
        float rs[8];
        { const LAS f32x4* tp = (const LAS f32x4*)(tab + ui * 256 + 128 * wr + 8 * fr); const f32x4 r0 = tp[0], r1 = tp[1];
          rs[0] = r0.x; rs[1] = r0.y; rs[2] = r0.z; rs[3] = r0.w; rs[4] = r1.x; rs[5] = r1.y; rs[6] = r1.z; rs[7] = r1.w; }
#pragma unroll
        for (int n = 0; n < 2; ++n) {
            const int hh = h0 + 4 * n;
            float* hp = halo + (size_t)G * 4 * NUP + (size_t)u.pn * 256 + tc0 + 4 * n;
            conv_inplace(acc, 0, n, rs, cw + hh, cb + hh, hp, fr);
            conv_inplace(acc, 1, n, rs, cw + FF + hh, cb + FF + hh, hp + 128, fr);
#pragma unroll
            for (int j = 0; j < 8; ++j) {
                const f32x4 cg_ = acc[j >> 2][0][j & 3][n], cu_ = acc[j >> 2][1][j & 3][n];
                f32x4 hv;
#pragma unroll
                for (int e = 0; e < 4; ++e) hv[e] = cg_[e] * fast_sigmoid(cg_[e]) * cu_[e];
                u32x2 w; w.x = cvt_pk_bf16(hv.x, hv.y); w.y = cvt_pk_bf16(hv.z, hv.w);
                *(u32x2*)(HID + (size_t)(T0 + j) * FF + hh) = w;
            }
        }
    }
};

struct Args { const float* in[29]; float* out; unsigned char* ws; int ph_lo, ph_hi; };

__device__ __forceinline__ void transpose_item(const float* W, int K, int N, const float* gk0, bf16_t* WT, int n0, int k0, int orow0, int lane) {
    const int kq = lane >> 4, nq = lane & 15;
    const float* src = W + (size_t)(k0 + 16 * kq) * N + n0 + 4 * nq;
    f32x4 v[16];
#pragma unroll
    for (int i = 0; i < 16; ++i) v[i] = *(const f32x4*)(src + (size_t)i * N);
    if (gk0) {
        const f32x4* gp = (const f32x4*)(gk0 + 16 * kq);
        const f32x4 g0 = gp[0], g1 = gp[1], g2 = gp[2], g3 = gp[3];
        v[0] *= g0.x; v[1] *= g0.y; v[2] *= g0.z; v[3] *= g0.w; v[4] *= g1.x; v[5] *= g1.y; v[6] *= g1.z; v[7] *= g1.w;
        v[8] *= g2.x; v[9] *= g2.y; v[10] *= g2.z; v[11] *= g2.w; v[12] *= g3.x; v[13] *= g3.y; v[14] *= g3.z; v[15] *= g3.w;
    }
#pragma unroll
    for (int e = 0; e < 4; ++e) {
        u32x4 o0, o1;
        o0.x = cvt_pk_bf16(v[0][e], v[1][e]); o0.y = cvt_pk_bf16(v[2][e], v[3][e]); o0.z = cvt_pk_bf16(v[4][e], v[5][e]); o0.w = cvt_pk_bf16(v[6][e], v[7][e]);
        o1.x = cvt_pk_bf16(v[8][e], v[9][e]); o1.y = cvt_pk_bf16(v[10][e], v[11][e]); o1.z = cvt_pk_bf16(v[12][e], v[13][e]); o1.w = cvt_pk_bf16(v[14][e], v[15][e]);
        bf16_t* dst = WT + (size_t)(orow0 + 4 * nq + e) * K + k0 + 16 * kq;
        *(u32x4*)dst = o0; *(u32x4*)(dst + 8) = o1;
    }
}

__device__ __forceinline__ double dsin_red(double r) {
    const double r2 = r * r; double term = r, s = r;
#pragma unroll 1
    for (int k = 1; k <= 14; ++k) { term *= -r2 / (double)((2 * k) * (2 * k + 1)); s += term; }
    return s;
}
__device__ __forceinline__ double dcos_red(double r) {
    const double r2 = r * r; double term = 1.0, s = 1.0;
#pragma unroll 1
    for (int k = 1; k <= 14; ++k) { term *= -r2 / (double)((2 * k - 1) * (2 * k)); s += term; }
    return s;
}
__device__ __forceinline__ double dexp_small(double x) {
    double term = 1.0, s = 1.0;
#pragma unroll 1
    for (int k = 1; k <= 16; ++k) { term *= x / (double)k; s += term; }
    return s;
}

__device__ __forceinline__ void prologue(const Args& a, unsigned char* lds_raw, const int g_wave) {
    unsigned char* ws = a.ws;
    int tid_ = THREAD_ID(); asm volatile("" : "+v"(tid_));
    const int tid = tid_, lane = tid & 63, wave = tid >> 6;
    const int G = gridDim.x, gw = blockIdx.x * 8 + wave, NGW = G * 8;
    const int gt = blockIdx.x * 512 + tid, NGT = G * 512;
    constexpr int I_IN = (DM / 64) * (NZ / 64), I_GLU = (DS / 64) * (DS / 64), I_OUT = (DM / 64) * (DM / 64), I_UP = (DM / 64) * (NUP / 64), I_DOWN = (FF / 64) * (DM / 64), I_GATE = (DM / 64) * (DM / 64), I_PROJ = (DP / 64) * (DM / 64);
    constexpr int I_LAYER = I_IN + I_GLU + I_OUT + I_UP + I_DOWN + I_GATE + I_PROJ;
    for (int it = gw; it < 2 * I_LAYER; it += NGW) {
        const int l = it / I_LAYER; int r = it % I_LAYER;
        unsigned char* wl = ws + WS_W + (size_t)l * W_LAYER;
        if (r < I_IN) { const int nblk = NZ / 64, kb = r / nblk, nb = r % nblk;
            transpose_item(a.in[3] + (size_t)l * DM * NZ, DM, NZ, a.in[2] + l * DM + kb * 64, (bf16_t*)(wl + W_IN), nb * 64, kb * 64, nb * 64, lane); continue; } r -= I_IN;
        if (r < I_GLU) { const int nblk = DS / 64, kb = r / nblk, nb = r % nblk;
            transpose_item(a.in[15] + (size_t)l * DS * DS, DS, DS, nullptr, (bf16_t*)(wl + W_GLU), nb * 64, kb * 64, nb * 64, lane); continue; } r -= I_GLU;
        if (r < I_OUT) { const int nblk = DM / 64, kb = r / nblk, nb = r % nblk; const int k0 = kb * 64;
            const float* gk = (k0 < DS) ? (a.in[17] + l * DS + k0) : (a.in[18] + l * DS + (k0 - DS));
            transpose_item(a.in[19] + (size_t)l * DM * DM, DM, DM, gk, (bf16_t*)(wl + W_OUT), nb * 64, k0, nb * 64, lane); continue; } r -= I_OUT;
        if (r < I_UP) { const int nblk = NUP / 64, kb = r / nblk, nb = r % nblk; const int n0 = nb * 64;
            const int bj = (n0 >= FF) ? 1 : 0, h = n0 - bj * FF, o0 = (h >> 7) * 256 + bj * 128 + (h & 127);
            transpose_item(a.in[21] + (size_t)l * DM * NUP, DM, NUP, a.in[20] + l * DM + kb * 64, (bf16_t*)(wl + W_UP), n0, kb * 64, o0, lane); continue; } r -= I_UP;
        if (r < I_DOWN) { const int nblk = DM / 64, kb = r / nblk, nb = r % nblk;
            transpose_item(a.in[24] + (size_t)l * FF * DM, FF, DM, nullptr, (bf16_t*)(wl + W_DOWN), nb * 64, kb * 64, nb * 64, lane); continue; } r -= I_DOWN;
        if (r < I_GATE) { const int nblk = DM / 64, kb = r / nblk, nb = r % nblk;
            transpose_item(a.in[26] + (size_t)l * DM * DM, DM, DM, a.in[25] + l * DM + kb * 64, (bf16_t*)(wl + W_GATE), nb * 64, kb * 64, nb * 64, lane); continue; } r -= I_GATE;
        { const int nblk = DM / 64, kb = r / nblk, nb = r % nblk;
            transpose_item(a.in[27] + (size_t)l * DP * DM, DP, DM, nullptr, (bf16_t*)(wl + W_PROJ), nb * 64, kb * 64, nb * 64, lane); }
    }
    {
        const float* x = a.in[0]; bf16_t* XB = (bf16_t*)(ws + WS_XB); float* st0 = (float*)(ws + WS_ST0);
        for (int row0 = gw; row0 < MTOK; row0 += 2 * NGW) {
            f32x4 v[2][8];
#pragma unroll
            for (int q = 0; q < 2; ++q) { const int row = (row0 + q * NGW < MTOK) ? row0 + q * NGW : row0; const f32x4* xr = (const f32x4*)(x + (size_t)row * DM) + lane;
#pragma unroll
                for (int j = 0; j < 8; ++j) v[q][j] = xr[64 * j]; }
#pragma unroll
            for (int q = 0; q < 2; ++q) { const int row = row0 + q * NGW; if (row >= MTOK) continue;
                float s = 0.f;
#pragma unroll
                for (int j = 0; j < 8; ++j) s += (v[q][j].x * v[q][j].x + v[q][j].y * v[q][j].y) + (v[q][j].z * v[q][j].z + v[q][j].w * v[q][j].w);
                s = wave_sum(s);
                u32x2* o = (u32x2*)(XB + (size_t)row * DM) + lane;
#pragma unroll
                for (int j = 0; j < 8; ++j) { u32x2 w; w.x = cvt_pk_bf16(v[q][j].x, v[q][j].y); w.y = cvt_pk_bf16(v[q][j].z, v[q][j].w); o[64 * j] = w; }
                if (lane < 32) st0[(size_t)row * 32 + lane] = (lane == 0) ? s : 0.f; }
        }
    }
    {
        const f32x4* p4 = (const f32x4*)a.in[1]; u32x2* o = (u32x2*)(ws + WS_PB);
        const int n4 = 2 * MTOK * DP / 4;
        for (int i0 = gt; i0 < n4; i0 += 8 * NGT) {
            f32x4 v[8];
#pragma unroll
            for (int j = 0; j < 8; ++j) { const int i = i0 + j * NGT; v[j] = (i < n4) ? p4[i] : (f32x4){0.f, 0.f, 0.f, 0.f}; }
#pragma unroll
            for (int j = 0; j < 8; ++j) { const int i = i0 + j * NGT; if (i < n4) { u32x2 w; w.x = cvt_pk_bf16(v[j].x, v[j].y); w.y = cvt_pk_bf16(v[j].z, v[j].w); o[i] = w; } }
        }
    }
    {
        const float* w = a.in[5]; bf16_t* o = (bf16_t*)(ws + WS_SGUW);
        for (int i = gt; i < 2 * 8 * 128 * 128; i += NGT) { const int s = i & 127, t = (i >> 7) & 127; const float v = (s <= t) ? w[i] : 0.f; o[i] = (bf16_t)(cvt_pk_bf16(v, 0.f) & 0xffffu); }
    }
    for (int i = gt; i < 2 * 64 * 64; i += NGT) {
        const int l = i >> 12, g = (i >> 6) & 63, n = i & 63;
        unsigned char* sp = ws + WS_S5P + (size_t)l * S5_LAYER;
        const double lr = (double)a.in[7][i], li = (double)a.in[8][i];
        const double dt = (double)expf(a.in[9][l * 64 + g]);
        const double mag = dexp_small(lr * dt);
        const double th = li * dt; const double kq = rint(th * 0.15915494309189533577); const double rr = th - kq * 6.283185307179586476925;
        const double abr = mag * dcos_red(rr), abi = mag * dsin_red(rr);
        const double den = lr * lr + li * li, nr = abr - 1.0;
        const double qr = (nr * lr + abi * li) / den, qi = (abi * lr - nr * li) / den;
        *(f32x2*)((float*)(sp + S5_AA) + ((size_t)g * 64 + n) * 2) = (f32x2){(float)abr, (float)abi};
        bf16_t* bc = (bf16_t*)(sp + S5_BCAT) + ((size_t)g * 128 + 2 * n) * 16;
        const float* bre = a.in[10] + (size_t)i * 16; const float* bim = a.in[11] + (size_t)i * 16;
#pragma unroll
        for (int c = 0; c < 16; c += 2) {
            const double r0 = bre[c], i0 = bim[c], r1 = bre[c + 1], i1 = bim[c + 1];
            *(unsigned*)(bc + c) = cvt_pk_bf16((float)(qr * r0 - qi * i0), (float)(qr * r1 - qi * i1));
            *(unsigned*)(bc + 16 + c) = cvt_pk_bf16((float)(qr * i0 + qi * r0), (float)(qr * i1 + qi * r1));
        }
        bf16_t* cm = (bf16_t*)(sp + S5_CMT) + (size_t)g * 16 * 128 + 2 * n;
        const float* cre = a.in[12] + ((size_t)(l * 64 + g) * 16) * 64 + n; const float* cim = a.in[13] + ((size_t)(l * 64 + g) * 16) * 64 + n;
#pragma unroll
        for (int c = 0; c < 16; ++c) *(unsigned*)(cm + c * 128) = cvt_pk_bf16(cre[c * 64], -cim[c * 64]);
    }
}

__device__ __forceinline__ void sgu_phase(const Args& a, int l, unsigned char* lds_raw, const int g_wave) {
    unsigned char* ws = a.ws;
    int tid_ = THREAD_ID(); asm volatile("" : "+v"(tid_));
    const int tid = tid_, lane = tid & 63, wid = tid >> 6, wr = wid >> 2, wc = wid & 3, fr = lane & 15, fq = lane >> 4;
    const bf16_t* Z = (const bf16_t*)(ws + WS_Z); bf16_t* MIX = (bf16_t*)(ws + WS_MIX);
    const float* vst = (const float*)(ws + WS_VST); float* yast = (float*)(ws + WS_YAST);
    const float* gsgu = a.in[4] + l * DS; const float* sb = a.in[6] + l * 8 * 128;
    const bf16_t* Wm = (const bf16_t*)(ws + WS_SGUW) + (size_t)l * 8 * 128 * 128;
    float* stat = (float*)lds_raw;
    bf16_t* vT0 = (bf16_t*)(lds_raw + 1024);
#define SGU_LOAD_V(hv, VV) do { const bf16_t* Zh = Z + 128 * (hv); \
        _Pragma("unroll") for (int i = 0; i < 4; ++i) VV[i] = *(const u32x4*)(Zh + DS + lnd(zvo[i])); } while (0)
#define SGU_LOAD_U(hv, UU, BI) do { const int h_ = (hv); const bf16_t* Zh = Z + 128 * h_; const float* sbh = sb + 128 * h_; \
        _Pragma("unroll") for (int m = 0; m < 4; ++m) { BI[m] = sbh[64 * wr + 16 * m + fr]; \
            _Pragma("unroll") for (int n = 0; n < 2; ++n) UU[m][n] = *(const u32x2*)(Zh + lnd(zuo[m]) + 16 * n); } } while (0)
#define SGU_LOAD_AF(hv) do { const bf16_t* Wh = Wm + (size_t)(hv) * 128 * 128; \
        _Pragma("unroll") for (int k = 0; k < 4; ++k) _Pragma("unroll") for (int m = 0; m < 4; ++m) af[k][m] = *(const bf16x8*)(Wh + lnd(wao) + 16 * 128 * m + 32 * k); } while (0)
#define SGU_STAGE(hv, VV, bufv) do { const int h_ = (hv); bf16_t* vT = vT0 + (bufv) * (128 * 136); const float* gh = gsgu + 128 * h_; \
        _Pragma("unroll") for (int i = 0; i < 4; ++i) { const int idx = tid + 512 * i, s = idx >> 4, c8 = idx & 15; \
            const float mean = stat[2 * s], rstd = stat[2 * s + 1]; \
            const f32x4 g0 = *(const f32x4*)(gh + 8 * c8), g1 = *(const f32x4*)(gh + 8 * c8 + 4); \
            float e[8]; \
            e[0] = (bf_lo(VV[i].x) - mean) * rstd * g0.x; e[1] = (bf_hi(VV[i].x) - mean) * rstd * g0.y; e[2] = (bf_lo(VV[i].y) - mean) * rstd * g0.z; e[3] = (bf_hi(VV[i].y) - mean) * rstd * g0.w; \
            e[4] = (bf_lo(VV[i].z) - mean) * rstd * g1.x; e[5] = (bf_hi(VV[i].z) - mean) * rstd * g1.y; e[6] = (bf_lo(VV[i].w) - mean) * rstd * g1.z; e[7] = (bf_hi(VV[i].w) - mean) * rstd * g1.w; \
            _Pragma("unroll") for (int j = 0; j < 8; ++j) vT[(8 * c8 + j) * 136 + (s ^ (c8 << 3))] = (bf16_t)(cvt_pk_bf16(e[j], 0.f) & 0xffffu); } } while (0)
#define SGU_MMA(bufv) do { const bf16_t* vT = vT0 + (bufv) * (128 * 136); \
        _Pragma("unroll") for (int m = 0; m < 4; ++m) { acc[m][0] = (f32x4){0.f, 0.f, 0.f, 0.f}; acc[m][1] = (f32x4){0.f, 0.f, 0.f, 0.f}; } \
        _Pragma("unroll") for (int k = 0; k < 4; ++k) { bf16x8 bf[2]; \
            _Pragma("unroll") for (int n = 0; n < 2; ++n) bf[n] = *(const bf16x8*)(vT + (32 * wc + 16 * n + fr) * 136 + 8 * ((4 * k + fq) ^ (((32 * wc + 16 * n + fr) >> 3) & 15))); \
            _Pragma("unroll") for (int m = 0; m < 4; ++m) _Pragma("unroll") for (int n = 0; n < 2; ++n) acc[m][n] = __builtin_amdgcn_mfma_f32_16x16x32_bf16(bf[n], af[k][m], acc[m][n], 0, 0, 0); } } while (0)
#define SGU_EPI(hv, UU, BI) do { const int h_ = (hv); bf16_t* Mh = MIX + 128 * h_; float* yh = yast + 4 * h_; \
        _Pragma("unroll") for (int m = 0; m < 4; ++m) { float ssq = 0.f; \
            _Pragma("unroll") for (int n = 0; n < 2; ++n) { const f32x4 q = acc[m][n] + BI[m]; \
                const float y0 = bf_lo(UU[m][n].x) * q.x, y1 = bf_hi(UU[m][n].x) * q.y, y2 = bf_lo(UU[m][n].y) * q.z, y3 = bf_hi(UU[m][n].y) * q.w; \
                ssq += (y0 * y0 + y1 * y1) + (y2 * y2 + y3 * y3); \
                u32x2 w; w.x = cvt_pk_bf16(y0, y1); w.y = cvt_pk_bf16(y2, y3); *(u32x2*)(Mh + lnd(mxo) + (unsigned)(16 * m) * DM + 16 * n) = w; } \
            ssq = red_fq(ssq); if (fq == 0) yh[lnd(yso) + 16 * 32 * m] = ssq; } } while (0)
    for (int chunk = blockIdx.x; chunk < MTOK / 128; chunk += gridDim.x) {
        const int T0 = chunk * 128;
        unsigned zvo[4], zuo[4];
#pragma unroll
        for (int i = 0; i < 4; ++i) { const int idx = tid + 512 * i, s_ = idx >> 4, c8 = idx & 15; zvo[i] = (unsigned)(T0 + s_) * NZ + 8 * c8; }
#pragma unroll
        for (int m = 0; m < 4; ++m) zuo[m] = (unsigned)(T0 + 64 * wr + 16 * m + fr) * NZ + 32 * wc + 4 * fq;
        const unsigned wao = (unsigned)(64 * wr + fr) * 128 + 8 * fq;
        const unsigned mxo = (unsigned)(T0 + 64 * wr + fr) * DM + 32 * wc + 4 * fq;
        const unsigned yso = (unsigned)(T0 + 64 * wr + fr) * 32 + wc;
        u32x4 vvA[4], vvB[4]; u32x2 uu[4][2]; float bi[4]; bf16x8 af[4][4]; f32x4 acc[4][2];
        SGU_LOAD_V(0, vvA); SGU_LOAD_AF(0); SGU_LOAD_U(0, uu, bi);
        __syncthreads();
        if (tid < 128) {
            const f32x4* p = (const f32x4*)(vst + (size_t)(T0 + tid) * 32);
            float s1 = 0.f, s2 = 0.f;
#pragma unroll
            for (int j = 0; j < 8; ++j) { const f32x4 q = p[j]; s1 += q.x + q.z; s2 += q.y + q.w; }
            const float mean = s1 * (1.0f / DS); const float var = s2 * (1.0f / DS) - mean * mean;
            stat[2 * tid] = mean; stat[2 * tid + 1] = __builtin_amdgcn_rsqf(fmaxf(var, 0.f) + EPS);
        }
        __syncthreads();
#pragma nounroll
        for (int h = 0; h < 8; h += 2) {
            const int h2 = (h + 2 < 8) ? h + 2 : 7;
            SGU_LOAD_V(h + 1, vvB);
            SGU_STAGE(h, vvA, 0); __syncthreads(); SGU_MMA(0); SGU_LOAD_AF(h + 1); SGU_EPI(h, uu, bi); SGU_LOAD_U(h + 1, uu, bi);
            SGU_LOAD_V(h2, vvA);
            SGU_STAGE(h + 1, vvB, 1); __syncthreads(); SGU_MMA(1); SGU_LOAD_AF(h2); SGU_EPI(h + 1, uu, bi); SGU_LOAD_U(h2, uu, bi);
        }
    }
#undef SGU_LOAD_V
#undef SGU_LOAD_U
#undef SGU_LOAD_AF
#undef SGU_STAGE
#undef SGU_MMA
#undef SGU_EPI
}

__device__ __forceinline__ void s5_phase(const Args& a, int l, unsigned char* lds_raw, const int g_wave) {
    unsigned char* ws = a.ws;
    int tid_ = THREAD_ID(); asm volatile("" : "+v"(tid_));
    const int tid = tid_, lane = tid & 63, wid = __builtin_amdgcn_readfirstlane(tid >> 6), fr = lane & 15, fq = lane >> 4;
    const bf16_t* Z = (const bf16_t*)(ws + WS_Z); bf16_t* ZS = (bf16_t*)(ws + WS_ZS);
    const unsigned char* sp = ws + WS_S5P + (size_t)l * S5_LAYER;
    const bf16_t* Bcat = (const bf16_t*)(sp + S5_BCAT); const bf16_t* CmT = (const bf16_t*)(sp + S5_CMT); const float* AA = (const float*)(sp + S5_AA);
    const float* dvec = a.in[14] + l * DS;
    constexpr int TC = 32, NCH = SEQ / TC;
    bf16_t* BUb = (bf16_t*)lds_raw;
    bf16_t* H = (bf16_t*)(lds_raw + 2 * 4 * TC * 136 * 2);
    const bf16x8 zero8 = (bf16x8){0, 0, 0, 0, 0, 0, 0, 0};
    for (int item = blockIdx.x; item < 256; item += gridDim.x) {
        const int b = item >> 4, gq = ((item & 15) + b) & 15;
        __syncthreads();
        if (wid < 4) {
            const f32x2 aa = *(const f32x2*)(AA + ((size_t)(4 * gq + wid) * 64 + lane) * 2);
            const float ar = aa.x, ai = aa.y, nai = -aa.y; float hr = 0.f, hi = 0.f;
#pragma nounroll
            for (int s = 0; s < NCH + 2; ++s) {
                if (s >= 1 && s <= NCH) {
                    const int ch = s - 1;
                    const unsigned* bu = (const unsigned*)(BUb + (size_t)(((ch & 1) * 4 + wid) * TC) * 136) + lane;
                    unsigned* hw = (unsigned*)(H + (size_t)(((ch & 1) * 4 + wid) * TC) * 136) + lane;
                    unsigned v[TC];
#pragma unroll
                    for (int t = 0; t < TC; ++t) v[t] = bu[t * 68];
#pragma unroll
                    for (int t = 0; t < TC; ++t) {
                        const float re = bf_lo(v[t]), im = bf_hi(v[t]); float tr, ti, nr, ni;
                        asm("v_fma_f32 %0, %1, %2, %3" : "=v"(tr) : "v"(nai), "v"(hi), "v"(re));
                        asm("v_fma_f32 %0, %1, %2, %3" : "=v"(ti) : "v"(ai), "v"(hr), "v"(im));
                        asm("v_fma_f32 %0, %1, %2, %3" : "=v"(nr) : "v"(ar), "v"(hr), "v"(tr));
                        asm("v_fma_f32 %0, %1, %2, %3" : "=v"(ni) : "v"(ar), "v"(hi), "v"(ti));
                        hr = nr; hi = ni;
                        hw[t * 68] = cvt_pk_bf16(hr, hi);
                    }
                }
                __syncthreads();
            }
        } else {
            const int gi = wid - 4, g = 4 * gq + gi;
            bf16x8 Bf[8], Cf[4];
#pragma unroll
            for (int nt = 0; nt < 8; ++nt) Bf[nt] = (fq < 2) ? *(const bf16x8*)(Bcat + ((size_t)g * 128 + 16 * nt + fr) * 16 + 8 * fq) : zero8;
#pragma unroll
            for (int k = 0; k < 4; ++k) Cf[k] = *(const bf16x8*)(CmT + ((size_t)g * 16 + fr) * 128 + 32 * k + 8 * fq);
            const f32x4 dv = *(const f32x4*)(dvec + 16 * g + 4 * fq);
            const bf16_t* zx = Z + ((size_t)b * SEQ + fr) * NZ + 2 * DS + 16 * g;
            bf16_t* zo = ZS + ((size_t)b * SEQ + fr) * DS + 16 * g + 4 * fq;
#define S5_LDF(c, mt) (*(const bf16x8*)(zx + (size_t)((c) * TC + 16 * (mt)) * NZ + 8 * (fq & 1)))
#define S5_LDY(c, mt) (*(const u32x2*)(zx + (size_t)((c) * TC + 16 * (mt)) * NZ + 4 * fq))
#define S5_BU1(sv, mt, XFv) do { const bf16x8 xz = (fq < 2) ? XFv : zero8; bf16_t* bw = BUb + (size_t)(((((sv) & 1) * 4 + gi) * TC) + 16 * (mt) + fr) * 136 + 4 * fq; \
        _Pragma("unroll") for (int nt = 0; nt < 8; ++nt) { const f32x4 r = __builtin_amdgcn_mfma_f32_16x16x32_bf16(Bf[nt], xz, (f32x4){0.f, 0.f, 0.f, 0.f}, 0, 0, 0); \
            u32x2 pk; pk.x = cvt_pk_bf16(r.x, r.y); pk.y = cvt_pk_bf16(r.z, r.w); *(u32x2*)(bw + 16 * nt) = pk; } } while (0)
#define S5_Y1(chv, mt, XYv) do { const int ch = (chv); f32x4 y = (f32x4){0.f, 0.f, 0.f, 0.f}; const bf16_t* hrow = H + (size_t)((((ch & 1) * 4 + gi) * TC) + 16 * (mt) + fr) * 136 + 8 * fq; \
        _Pragma("unroll") for (int k = 0; k < 4; ++k) { const bf16x8 hf = *(const bf16x8*)(hrow + 32 * k); y = __builtin_amdgcn_mfma_f32_16x16x32_bf16(Cf[k], hf, y, 0, 0, 0); } \
        const float y0 = y.x + dv.x * bf_lo(XYv.x), y1 = y.y + dv.y * bf_hi(XYv.x), y2 = y.z + dv.z * bf_lo(XYv.y), y3 = y.w + dv.w * bf_hi(XYv.y); \
        u32x2 w; w.x = cvt_pk_bf16(gelu_tanh(y0), gelu_tanh(y1)); w.y = cvt_pk_bf16(gelu_tanh(y2), gelu_tanh(y3)); \
        *(u32x2*)(zo + (size_t)(ch * TC + 16 * (mt)) * DS) = w; } while (0)
            bf16x8 XF0a = S5_LDF(0, 0), XF0b = S5_LDF(0, 1), XF1a = S5_LDF(1, 0), XF1b = S5_LDF(1, 1), XF2a = S5_LDF(2, 0), XF2b = S5_LDF(2, 1), XF3a = S5_LDF(3, 0), XF3b = S5_LDF(3, 1);
            u32x2 XY0a = S5_LDY(0, 0), XY0b = S5_LDY(0, 1), XY1a = S5_LDY(1, 0), XY1b = S5_LDY(1, 1), XY2a = S5_LDY(2, 0), XY2b = S5_LDY(2, 1), XY3a = S5_LDY(3, 0), XY3b = S5_LDY(3, 1);
#define S5_CL(c) (((c) < NCH) ? (c) : NCH - 1)
#define S5_STEP_BU(sv, XFa, XFb) do { S5_BU1(sv, 0, XFa); S5_BU1(sv, 1, XFb); XFa = S5_LDF(S5_CL((sv) + 4), 0); XFb = S5_LDF(S5_CL((sv) + 4), 1); } while (0)
#define S5_STEP_Y(sv, XYa, XYb) do { S5_Y1((sv) - 2, 0, XYa); S5_Y1((sv) - 2, 1, XYb); XYa = S5_LDY(S5_CL((sv) + 2), 0); XYb = S5_LDY(S5_CL((sv) + 2), 1); } while (0)
            S5_STEP_BU(0, XF0a, XF0b); __syncthreads();
            S5_STEP_BU(1, XF1a, XF1b); __syncthreads();
            S5_STEP_BU(2, XF2a, XF2b); S5_STEP_Y(2, XY0a, XY0b); __syncthreads();
            S5_STEP_BU(3, XF3a, XF3b); S5_STEP_Y(3, XY1a, XY1b); __syncthreads();
#pragma nounroll
            for (int s = 4; s < NCH; s += 4) {
                S5_STEP_BU(s, XF0a, XF0b); S5_STEP_Y(s, XY2a, XY2b); __syncthreads();
                S5_STEP_BU(s + 1, XF1a, XF1b); S5_STEP_Y(s + 1, XY3a, XY3b); __syncthreads();
                S5_STEP_BU(s + 2, XF2a, XF2b); S5_STEP_Y(s + 2, XY0a, XY0b); __syncthreads();
                S5_STEP_BU(s + 3, XF3a, XF3b); S5_STEP_Y(s + 3, XY1a, XY1b); __syncthreads();
            }
            S5_Y1(NCH - 2, 0, XY2a); S5_Y1(NCH - 2, 1, XY2b); __syncthreads();
            S5_Y1(NCH - 1, 0, XY3a); S5_Y1(NCH - 1, 1, XY3b); __syncthreads();
#undef S5_CL
#undef S5_STEP_BU
#undef S5_STEP_Y
#undef S5_BU1
#undef S5_Y1
#undef S5_LDF
#undef S5_LDY
        }
    }
    __syncthreads();
}

__device__ __forceinline__ void fixup_phase(const Args& a, int l, const pg8::StaticOrder& S, const int g_wave) {
    unsigned char* ws = a.ws;
    const float* halo = (const float*)(ws + WS_HALO); bf16_t* HID = (bf16_t*)(ws + WS_HID);
    const float* cw = a.in[22] + (size_t)l * 3 * NUP; const float* cb = a.in[23] + (size_t)l * NUP;
    int tid_ = THREAD_ID(); asm volatile("" : "+v"(tid_));
    constexpr int NQ = FF / 4;
    Unit u; int last_pm = -1;
    for (int ui = 0; S.next(ui, u); ++ui) {
      if (u.pm == last_pm) continue;
      last_pm = u.pm;
      for (int q = tid_; q < NQ; q += 512) {
        const int h = 4 * q, pn = h >> 7, tcg = pn * 256 + (h & 127), tcu = tcg + 128;
        const f32x4 w0g = *(const f32x4*)(cw + h), w1g = *(const f32x4*)(cw + NUP + h), w2g = *(const f32x4*)(cw + 2 * NUP + h), bg = *(const f32x4*)(cb + h);
        const f32x4 w0u = *(const f32x4*)(cw + FF + h), w1u = *(const f32x4*)(cw + NUP + FF + h), w2u = *(const f32x4*)(cw + 2 * NUP + FF + h), bu = *(const f32x4*)(cb + FF + h);
        f32x4 a0g[2], a1g[2], p2g[2], p3g[2], a0u[2], a1u[2], p2u[2], p3u[2];
#pragma unroll
        for (int gi = 0; gi < 2; ++gi) {
            const int G = 2 * u.pm + gi; const bool first = (G & 15) == 0;
            const float* hg = halo + (size_t)G * 4 * NUP; const float* hp = first ? hg : hg - (size_t)4 * NUP;
            a0g[gi] = *(const f32x4*)(hg + tcg); a0u[gi] = *(const f32x4*)(hg + tcu);
            a1g[gi] = *(const f32x4*)(hg + NUP + tcg); a1u[gi] = *(const f32x4*)(hg + NUP + tcu);
            p2g[gi] = *(const f32x4*)(hp + 2 * NUP + tcg); p2u[gi] = *(const f32x4*)(hp + 2 * NUP + tcu);
            p3g[gi] = *(const f32x4*)(hp + 3 * NUP + tcg); p3u[gi] = *(const f32x4*)(hp + 3 * NUP + tcu);
        }
#pragma unroll
        for (int gi = 0; gi < 2; ++gi) {
            const int G = 2 * u.pm + gi; const bool first = (G & 15) == 0;
            const f32x4 z4 = (f32x4){0.f, 0.f, 0.f, 0.f};
            const f32x4 q2g = first ? z4 : p2g[gi], q3g = first ? z4 : p3g[gi], q2u = first ? z4 : p2u[gi], q3u = first ? z4 : p3u[gi];
#pragma unroll
            for (int ri = 0; ri < 2; ++ri) {
                const f32x4 g2 = ri ? a1g[gi] : a0g[gi], g1 = ri ? a0g[gi] : q3g, g0 = ri ? q3g : q2g;
                const f32x4 u2 = ri ? a1u[gi] : a0u[gi], u1 = ri ? a0u[gi] : q3u, u0 = ri ? q3u : q2u;
                const f32x4 cg_ = w2g * g2 + (w1g * g1 + (w0g * g0 + bg)), cu_ = w2u * u2 + (w1u * u1 + (w0u * u0 + bu));
                f32x4 hv;
#pragma unroll
                for (int e = 0; e < 4; ++e) hv[e] = cg_[e] * fast_sigmoid(cg_[e]) * cu_[e];
                u32x2 w; w.x = cvt_pk_bf16(hv.x, hv.y); w.y = cvt_pk_bf16(hv.z, hv.w);
                *(u32x2*)(HID + (size_t)(G * 128 + ri) * FF + h) = w;
            }
        }
      }
    }
    asm volatile("s_waitcnt vmcnt(0)" ::: "memory");
    __syncthreads();
}

__device__ __forceinline__ void final_phase(const Args& a, const float* st, const bf16_t* X, const int g_wave) {
    int tid_ = THREAD_ID(); asm volatile("" : "+v"(tid_));
    const int lane = tid_ & 63, wave = tid_ >> 6;
    const int gw = blockIdx.x * 8 + wave, NGW = gridDim.x * 8;
    const float* gf = a.in[28];
    f32x4 g0[4], g1[4];
#pragma unroll
    for (int j = 0; j < 4; ++j) { g0[j] = *(const f32x4*)(gf + 512 * j + 8 * lane); g1[j] = *(const f32x4*)(gf + 512 * j + 8 * lane + 4); }
    for (int row0 = gw; row0 < MTOK; row0 += 4 * NGW) {
        float s[4]; u32x4 xv[4][4];
#pragma unroll
        for (int q = 0; q < 4; ++q) { const int row = row0 + q * NGW; const bool ok = row < MTOK; const int r = ok ? row : row0;
            s[q] = (lane < 32) ? st[(size_t)r * 32 + lane] : 0.f;
            const u32x4* xr = (const u32x4*)(X + (size_t)r * DM) + lane;
#pragma unroll
            for (int j = 0; j < 4; ++j) xv[q][j] = xr[64 * j]; }
#pragma unroll
        for (int q = 0; q < 4; ++q) { const int row = row0 + q * NGW; if (row >= MTOK) continue;
            const float rs = __builtin_amdgcn_rsqf(wave_sum(s[q]) * (1.0f / DM) + EPS);
            float* orow = a.out + (size_t)row * DM + 8 * lane;
#pragma unroll
            for (int j = 0; j < 4; ++j) { f32x4 v0, v1; unpack8(xv[q][j], v0, v1);
                *(f32x4*)(orow + 512 * j) = v0 * rs * g0[j]; *(f32x4*)(orow + 512 * j + 4) = v1 * rs * g1[j]; } }
    }
}

template <int MODE> __device__ __forceinline__ void fill_tab(float* tab, const pg8::StaticOrder& S, const float* st, const float* st2, const int g_wave) {
    int tid_ = THREAD_ID(); asm volatile("" : "+v"(tid_));
    constexpr int NB = (MODE == 0) ? 4 : 2;
    for (int base = tid_; ; base += NB * 512) {
        Unit u; int row[NB]; bool ok[NB]; f32x4 p[NB][8]; f32x4 q[NB][4];
#pragma unroll
        for (int b = 0; b < NB; ++b) { const int idx = base + b * 512; ok[b] = S.next(idx >> 8, u); row[b] = ok[b] ? u.pm * 256 + (idx & 255) : 0;
            const f32x4* sp = (const f32x4*)(st + (size_t)row[b] * 32);
#pragma unroll
            for (int j = 0; j < 8; ++j) p[b][j] = sp[j];
            if (MODE == 1) { const f32x4* sq = (const f32x4*)(st2 + (size_t)row[b] * 16);
#pragma unroll
                for (int j = 0; j < 4; ++j) q[b][j] = sq[j]; } }
        if (!ok[0]) break;
#pragma unroll
        for (int b = 0; b < NB; ++b) { if (!ok[b]) continue; const int idx = base + b * 512;
            float s = 0.f;
#pragma unroll
            for (int j = 0; j < 8; ++j) s += (p[b][j].x + p[b][j].y) + (p[b][j].z + p[b][j].w);
            if (MODE == 0) tab[idx] = __builtin_amdgcn_rsqf(s * (1.0f / DM) + EPS);
            else { float s2 = 0.f;
#pragma unroll
                for (int j = 0; j < 4; ++j) s2 += (q[b][j].x + q[b][j].y) + (q[b][j].z + q[b][j].w);
                const float ra = __builtin_amdgcn_rsqf(s * (1.0f / DS) + EPS), rb = __builtin_amdgcn_rsqf(s2 * (1.0f / DS) + EPS);
                tab[idx] = ra / rb; tab[1024 + idx] = rb; } }
    }
    __syncthreads();
}

#define XB_TMO      128
#define XB_XCNT(j)  (256  + 64 * (j))
#define XB_XSUB(j)  (1280 + 64 * (j))
#define XB_XGEN(j)  (2304 + 64 * (j))
#define XB_TOP      3328
#define XB_TOPGEN   3392
#define XCD_BAR_WORDS 3456
#define XB_SPIN_CAP (1u << 18)
__device__ __forceinline__ unsigned xb_ld(unsigned* p)              { return __hip_atomic_load(p, __ATOMIC_RELAXED, __HIP_MEMORY_SCOPE_AGENT); }
__device__ __forceinline__ unsigned xb_add(unsigned* p, unsigned v) { return __hip_atomic_fetch_add(p, v, __ATOMIC_RELAXED, __HIP_MEMORY_SCOPE_AGENT); }
__device__ __forceinline__ unsigned xb_xcc_id() { return (unsigned)__builtin_amdgcn_s_getreg((3 << 11) | 20) & 0xFu; }
#define XB_SPIN(cond, bar) do { unsigned _sp = 0; while (cond) { __builtin_amdgcn_s_sleep(1); \
    if ((++_sp & 255u) == 0u) { if (xb_ld(&(bar)[XB_TMO])) break; if (_sp > XB_SPIN_CAP) { atomicAdd(&(bar)[XB_TMO], 1u); break; } } } } while (0)
struct XcdBarrier { unsigned* bar; unsigned x; volatile LAS unsigned* st; };
__device__ __forceinline__ XcdBarrier xcd_barrier_post(unsigned* bar, volatile LAS unsigned* st, const int g_wave) {
    XcdBarrier b; b.bar = bar; b.x = xb_xcc_id(); b.st = st;
    if (THREAD_ID() == 0) (void)xb_add(&bar[XB_XCNT(b.x)], 1u);
    return b;
}
__device__ __forceinline__ void xcd_barrier_complete(unsigned* bar, unsigned x, unsigned& nloc, unsigned& nx) {
    const unsigned G = gridDim.x * gridDim.y * gridDim.z;
    unsigned sum, cnt, mine, sp = 0u;
    for (;;) {
        sum = 0u; cnt = 0u; mine = 0u;
#pragma unroll
        for (unsigned j = 0; j < 16; ++j) { const unsigned c = xb_ld(&bar[XB_XCNT(j)]); sum += c; cnt += (c > 0u) ? 1u : 0u; mine = (j == x) ? c : mine; }
        if (sum == G) break;
        __builtin_amdgcn_s_sleep(1);
        if ((++sp & 255u) == 0u) { if (xb_ld(&bar[XB_TMO])) break; if (sp > XB_SPIN_CAP) { atomicAdd(&bar[XB_TMO], 1u); break; } }
    }
    nloc = mine > 0u ? mine : 1u; nx = cnt > 0u ? cnt : 1u;
}
__device__ __forceinline__ void xcd_barrier(const XcdBarrier& b, const int g_wave) {
    asm volatile("s_waitcnt vmcnt(0)" ::: "memory");
    __syncthreads();
    if (THREAD_ID() == 0) {
        unsigned* bar = b.bar;
        __builtin_amdgcn_s_waitcnt(0);
        unsigned nloc = b.st[0], nx = b.st[1];
        if (nloc == 0u) { xcd_barrier_complete(bar, b.x, nloc, nx); b.st[0] = nloc; b.st[1] = nx; }
        const unsigned old = xb_add(&bar[XB_XSUB(b.x)], 1u);
        const unsigned gen = old / nloc;
        if (old + 1u == (gen + 1u) * nloc) {
            __builtin_amdgcn_fence(__ATOMIC_RELEASE, "agent");
            asm volatile("s_waitcnt vmcnt(0)" ::: "memory");
            const unsigned og = xb_add(&bar[XB_TOP], 1u);
            const unsigned tg = og / nx;
            if (og + 1u == (tg + 1u) * nx) xb_add(&bar[XB_TOPGEN], 1u);
            else XB_SPIN(xb_ld(&bar[XB_TOPGEN]) == tg, bar);
            __builtin_amdgcn_fence(__ATOMIC_ACQUIRE, "agent");
            xb_add(&bar[XB_XGEN(b.x)], 1u);
            asm volatile("s_waitcnt vmcnt(0)" ::: "memory");
        } else {
            XB_SPIN(xb_ld(&bar[XB_XGEN(b.x)]) == gen, bar);
            __builtin_amdgcn_fence(__ATOMIC_ACQUIRE, "agent");
            asm volatile("s_waitcnt vmcnt(0)" ::: "memory");
        }
    }
    __syncthreads();
}

__global__ void __launch_bounds__(512, 2) fwd_kernel(Args a0) {
    extern __shared__ __attribute__((aligned(16))) unsigned char lds_raw[];
    LAS unsigned char* lds = (LAS unsigned char*)lds_raw;
    cg::grid_group grid = cg::this_grid();
    float* tabg = (float*)(lds_raw + LDS_RING); const LAS float* tabl = (const LAS float*)(lds + LDS_RING);
    const int ph_hi = a0.ph_hi;
    const int g_wave = __builtin_amdgcn_readfirstlane((int)threadIdx.x >> 6);
    if (THREAD_ID() < 16) ((volatile LAS unsigned*)(lds + LDS_MISC))[THREAD_ID()] = 0u;
    __syncthreads();
    (void)xcd_barrier_post((unsigned*)(a0.ws + WS_CTL), (volatile LAS unsigned*)(lds + LDS_MISC), g_wave);
#pragma nounroll
    for (int ph = a0.ph_lo; ph < ph_hi; ++ph) {
#if defined(__HIP_DEVICE_COMPILE__)
        const __attribute__((address_space(4))) Args* ap = (const __attribute__((address_space(4))) Args*)__builtin_amdgcn_kernarg_segment_ptr();
        asm volatile("" : "+s"(ap));
        Args a;
#pragma unroll
        for (int i = 0; i < 29; ++i) a.in[i] = ap->in[i];
        a.out = ap->out; a.ws = ap->ws; a.ph_lo = 0; a.ph_hi = 0;
#else
        const Args a = a0;
#endif
        unsigned char* ws = a.ws;
        int G = gridDim.x, cblk = blockIdx.x; asm volatile("" : "+s"(G), "+s"(cblk));
        if (ph == 0) {
            if constexpr (PHON(8)) for (int rep = 0; rep < DUPN(8); ++rep) { prologue(a, lds_raw, g_wave); __syncthreads(); }
        } else if (ph == 15) {
            if constexpr (PHON(9)) final_phase(a, (const float*)(ws + WS_ST0), (const bf16_t*)(ws + WS_XB), g_wave);
        } else {
            const int l = (ph - 1) / 7, s = (ph - 1) % 7;
            unsigned char* wl = ws + WS_W + (size_t)l * W_LAYER;
            float* stA = (float*)(ws + (l == 0 ? WS_ST0 : WS_ST1));
            float* stB = (float*)(ws + (l == 0 ? WS_ST1 : WS_ST0));
            bf16_t* XP = (bf16_t*)(ws + (l == 0 ? WS_XB : WS_PROJ));
            bf16_t* XQ = (bf16_t*)(ws + (l == 0 ? WS_PROJ : WS_XB));
            pg8::StaticOrder S;
            if (s == 0) {  if constexpr (PHON(0)) {
                pg8::Gemm g{XP, (const bf16_t*)(wl + W_IN), MTOK, NZ, DM}; S.init(MTOK, NZ, G, cblk);
                fill_tab<0>(tabg, S, stA, nullptr, g_wave);
                EpiWin E{tabl, (bf16_t*)(ws + WS_Z), (float*)(ws + WS_VST)};
                for (int rep = 0; rep < DUPN(0); ++rep) pg8::gemm_phase<EpiWin>(lds, g, S, E, g_wave); }
            } else if (s == 1) {  if constexpr (PHON(1)) {
                for (int rep = 0; rep < DUPN(1); ++rep) { sgu_phase(a, l, lds_raw, g_wave); __syncthreads(); }
                for (int rep = 0; rep < DUPN(10); ++rep) { s5_phase(a, l, lds_raw, g_wave); __syncthreads(); } }
            } else if (s == 2) {  if constexpr (PHON(2)) {
                pg8::Gemm g{(const bf16_t*)(ws + WS_ZS), (const bf16_t*)(wl + W_GLU), MTOK, DS, DS}; S.init(MTOK, DS, G, cblk);
                EpiGlu E{(const bf16_t*)(ws + WS_ZS), a.in[16] + l * DS, (bf16_t*)(ws + WS_MIX), (float*)(ws + WS_YBST)};
                for (int rep = 0; rep < DUPN(2); ++rep) pg8::gemm_phase<EpiGlu>(lds, g, S, E, g_wave); }
            } else if (s == 3) {  if constexpr (PHON(3)) {
                pg8::Gemm g{(const bf16_t*)(ws + WS_MIX), (const bf16_t*)(wl + W_OUT), MTOK, DM, DM}; S.init(MTOK, DM, G, cblk);
                fill_tab<1>(tabg, S, (const float*)(ws + WS_YAST), (const float*)(ws + WS_YBST), g_wave);
                EpiWout E{tabl, XP, stB};
                pg8::gemm_phase<EpiWout>(lds, g, S, E, g_wave); }
            } else if (s == 4) {  if constexpr (PHON(4)) {
                { pg8::Gemm g{XP, (const bf16_t*)(wl + W_UP), MTOK, NUP, DM}; S.init(MTOK, NUP, G, cblk);
                  fill_tab<0>(tabg, S, stB, nullptr, g_wave);
                  EpiUp E{tabl, a.in[22] + (size_t)l * 3 * NUP, a.in[23] + (size_t)l * NUP, (bf16_t*)(ws + WS_HID), (float*)(ws + WS_HALO)};
                  for (int rep = 0; rep < DUPN(4); ++rep) pg8::gemm_phase<EpiUp>(lds, g, S, E, g_wave); }
                { pg8::Gemm g{(const bf16_t*)(ws + WS_PB) + (size_t)l * MTOK * DP, (const bf16_t*)(wl + W_PROJ), MTOK, DM, DP}; S.init(MTOK, DM, G, cblk);
                  EpiProj E{XQ};
                  for (int rep = 0; rep < DUPN(5); ++rep) pg8::gemm_phase<EpiProj>(lds, g, S, E, g_wave); } }
            } else if (s == 5) {  if constexpr (PHON(6)) {
                pg8::Gemm g{(const bf16_t*)(ws + WS_HID), (const bf16_t*)(wl + W_DOWN), MTOK, DM, FF}; S.init(MTOK, DM, G, cblk);
                fixup_phase(a, l, S, g_wave);
                EpiDown E{XP, stA};
                pg8::gemm_phase<EpiDown>(lds, g, S, E, g_wave); }
            } else {  if constexpr (PHON(7)) {
                pg8::Gemm g{XP, (const bf16_t*)(wl + W_GATE), MTOK, DM, DM}; S.init(MTOK, DM, G, cblk);
                fill_tab<0>(tabg, S, stA, nullptr, g_wave);
                EpiGate E{tabl, XP, XQ, stB};
                pg8::gemm_phase<EpiGate>(lds, g, S, E, g_wave); }
            }
        }
#ifndef EXTRA_SYNCS
#define EXTRA_SYNCS 0
#endif
        if (ph + 1 < ph_hi) {
            if (ph_hi > 1000) grid.sync();
            XcdBarrier xb; xb.bar = (unsigned*)(ws + WS_CTL); xb.x = xb_xcc_id(); xb.st = (volatile LAS unsigned*)(lds + LDS_MISC);
            xcd_barrier(xb, g_wave); for (int e = 0; e < EXTRA_SYNCS; ++e) xcd_barrier(xb, g_wave);
        }
    }
}

extern "C" void kernel_launch(void* const* d_in, const int* in_sizes, int n_in, void* d_out, int out_size, void* d_ws, size_t ws_size, hipStream_t stream) {
    static int grid = 0;
    if (grid == 0) {
        if (n_in != 29 || ws_size < WS_END) { fprintf(stderr, "kernel_launch: unexpected n_in %d / ws_size %zu\n", n_in, ws_size); grid = -1; return; }
        int dev = 0, cus = 0, per_cu = 0;
        hipGetDevice(&dev);
        hipDeviceGetAttribute(&cus, hipDeviceAttributeMultiprocessorCount, dev);
        if (hipFuncSetAttribute((const void*)fwd_kernel, hipFuncAttributeMaxDynamicSharedMemorySize, LDS_BYTES) != hipSuccess) { fprintf(stderr, "kernel_launch: hipFuncSetAttribute failed\n"); grid = -1; return; }
        hipOccupancyMaxActiveBlocksPerMultiprocessor(&per_cu, (const void*)fwd_kernel, 512, LDS_BYTES);
        (void)hipGetLastError();
        if (per_cu < 1) per_cu = 1;
        grid = cus * 1;
        if (grid <= 0) grid = 256;
    }
    if (grid < 0) return;
    if (hipMemsetAsync((char*)d_ws + WS_CTL, 0, CTL_BYTES, stream) != hipSuccess) { fprintf(stderr, "kernel_launch: memset of the barrier words failed\n"); return; }
    Args a{};
    for (int i = 0; i < 29; ++i) a.in[i] = (const float*)d_in[i];
    a.out = (float*)d_out; a.ws = (unsigned char*)d_ws;
#if MULTI_LAUNCH
    for (int ph = 0; ph < 16; ++ph) {
        a.ph_lo = ph; a.ph_hi = ph + 1;
        hipLaunchKernelGGL(fwd_kernel, dim3(grid), dim3(512), LDS_BYTES, stream, a);
    }
#else
    a.ph_lo = 0; a.ph_hi = 16;
    void* args[] = {&a};
    hipError_t e = hipLaunchCooperativeKernel((const void*)fwd_kernel, dim3(grid), dim3(512), args, LDS_BYTES, stream);
    if (e != hipSuccess) fprintf(stderr, "cooperative launch failed: %s (grid %d)\n", hipGetErrorString(e), grid);
#endif
}
```
